# Optimizing an MI355X kernel written in HIP

```python
import math
import jax
import jax.numpy as jnp
from jax import lax
import numpy as np


D_MODEL = 1024
BATCH = 16
SEQ = 2048
DEPTH = 2

MIX_WIDTH = D_MODEL
DA_HEADS = 4
DA_QK_DIM = 64
DA_V_DIM = 2 * DA_QK_DIM
DA_WIDTH = DA_HEADS * DA_V_DIM
GLA_HEADS = 4
GLA_V_DIM = 64
GLA_K_DIM = GLA_V_DIM // 2
GLA_WIDTH = GLA_HEADS * GLA_V_DIM
GLA_GATE_RANK = 16
GLA_GATE_NORM = 16.0
GLA_CHUNK = 64
POOL_WINDOWS = (2, 4, 8, 16)
POOL_GROUPS = 4
POOL_WIDTH = MIX_WIDTH - DA_WIDTH - GLA_WIDTH
POOL_GROUP_DIM = POOL_WIDTH // POOL_GROUPS
DA_Q_COLS = DA_HEADS * 2 * DA_QK_DIM
DA_K_COLS = DA_HEADS * 2 * DA_QK_DIM
DA_V_COLS = DA_WIDTH
GLA_Q_COLS = GLA_HEADS * GLA_K_DIM
GLA_K_COLS = GLA_HEADS * GLA_K_DIM
GLA_V_COLS = GLA_WIDTH
GLA_R_COLS = GLA_WIDTH
IN_SIZES = (DA_Q_COLS, DA_K_COLS, DA_V_COLS, GLA_Q_COLS, GLA_K_COLS, GLA_V_COLS, GLA_GATE_RANK, GLA_R_COLS, POOL_WIDTH)
IN_TOTAL = sum(IN_SIZES)
FFN_HIDDEN = -(-8 * D_MODEL // (3 * 256)) * 256
REL_BUCKETS = 32
REL_MAX_DIST = 128
Q_BLOCK = 128
EPS = 1e-6

kernel_name = 'hymba_style_diffattn_gla_pool_hybrid'


def rms_norm(x, g):
    xf = x.astype(jnp.float32)
    y = xf * lax.rsqrt(jnp.mean(xf * xf, axis=-1, keepdims=True) + EPS)
    return (y * g.astype(jnp.float32)).astype(x.dtype)


def t5_bucket(dist):
    max_exact = REL_BUCKETS // 2
    d = jnp.maximum(dist, 0)
    large = max_exact + (jnp.log(jnp.maximum(d, 1).astype(jnp.float32) / max_exact)
                         / math.log(REL_MAX_DIST / max_exact) * (REL_BUCKETS - max_exact)).astype(jnp.int32)
    large = jnp.minimum(large, REL_BUCKETS - 1)
    return jnp.where(d < max_exact, d, large)


def diff_attention(q, k, v, lam, bias_by_dist):
    S = q.shape[1]
    scale = DA_QK_DIM ** -0.5
    outs = []
    for i in range(S // Q_BLOCK):
        q0 = i * Q_BLOCK
        kend = q0 + Q_BLOCK
        qb = q[:, q0:kend]
        kb = k[:, :kend]
        vb = v[:, :kend]
        s = jnp.einsum('bqhmd,bkhmd->bhmqk', qb, kb).astype(jnp.float32) * scale
        dist = jnp.arange(q0, kend)[:, None] - jnp.arange(kend)[None, :]
        bias = bias_by_dist[jnp.clip(dist, 0, S - 1)].astype(jnp.float32)
        s = s + jnp.transpose(bias, (2, 0, 1))[None, :, None]
        s = jnp.where(dist[None, None, None] >= 0, s, -1e30)
        p = jax.nn.softmax(s, axis=-1)
        w = p[:, :, 0] - lam * p[:, :, 1]
        outs.append(jnp.einsum('bhqk,bkhd->bqhd', w.astype(v.dtype), vb))
    return jnp.concatenate(outs, axis=1)


def gla_chunked(q, k, v, log_a):
    B, S, H, dk = q.shape
    dv = v.shape[-1]
    C = GLA_CHUNK
    N = S // C

    def chunkify(t):
        return t.astype(jnp.float32).reshape(B, N, C, H, t.shape[-1]).transpose(1, 0, 3, 2, 4)

    qc = chunkify(q) * (dk ** -0.5)
    kc = chunkify(k)
    vc = chunkify(v)
    b = jnp.cumsum(chunkify(log_a), axis=3)
    q_dec = qc * jnp.exp(b)
    k_inv = kc * jnp.exp(-b)
    k_end = kc * jnp.exp(b[..., -1:, :] - b)
    chunk_decay = jnp.exp(b[..., -1, :])
    causal = jnp.tril(jnp.ones((C, C), jnp.float32))
    attn = jnp.einsum('nbhqd,nbhkd->nbhqk', q_dec, k_inv) * causal
    o_intra = jnp.einsum('nbhqk,nbhkv->nbhqv', attn, vc)

    def step(state, inp):
        q_c, k_c, v_c, dec_c = inp
        o_inter = jnp.einsum('bhqd,bhdv->bhqv', q_c, state)
        state = state * dec_c[..., None] + jnp.einsum('bhkd,bhkv->bhdv', k_c, v_c)
        return state, o_inter

    state0 = jnp.zeros((B, H, dk, dv), jnp.float32)
    _, o_inter = lax.scan(step, state0, (q_dec, k_end, vc, chunk_decay))
    o = o_intra + o_inter
    return o.transpose(1, 0, 3, 2, 4).reshape(B, S, H, dv).astype(v.dtype)


def multiscale_pool(u, pool_w, pool_scale):
    B, S, _ = u.shape
    uf = u.astype(jnp.float32)
    cs = jnp.concatenate([jnp.zeros((B, 1, POOL_WIDTH), jnp.float32), jnp.cumsum(uf, axis=1)], axis=1)
    t = jnp.arange(S)
    outs = []
    for g, win in enumerate(POOL_WINDOWS):
        lo, hi = g * POOL_GROUP_DIM, (g + 1) * POOL_GROUP_DIM
        csg = cs[..., lo:hi]
        prev = jnp.concatenate([jnp.zeros((B, win - 1, POOL_GROUP_DIM), jnp.float32), csg[:, :S + 1 - win]], axis=1)
        count = jnp.minimum(t + 1, win).astype(jnp.float32)
        pooled = (csg[:, 1:] - prev) / count[None, :, None] - uf[..., lo:hi]
        outs.append(jnp.einsum('bsc,cd->bsd', pooled, pool_w[g].astype(jnp.float32)))
    y = jnp.concatenate(outs, axis=-1) * pool_scale.astype(jnp.float32)
    return y.astype(u.dtype)


def setup_inputs(seed: int = 0) -> dict:
    key = jax.random.key(seed)
    ks = jax.random.split(key, 18)
    f32 = jnp.float32

    def nrm(k, shape, scale):
        return jax.random.normal(k, shape, f32) * scale

    def gain(k, shape):
        return 1.0 + 0.1 * jax.random.normal(k, shape, f32)

    return {
        'x': nrm(ks[0], (BATCH, SEQ, D_MODEL), 1.0),
        'attn_norm_g': gain(ks[1], (DEPTH, D_MODEL)),
        'w_in': nrm(ks[2], (DEPTH, D_MODEL, IN_TOTAL), D_MODEL ** -0.5),
        'q_norm_g': gain(ks[3], (DEPTH, DA_QK_DIM)),
        'k_norm_g': gain(ks[4], (DEPTH, DA_QK_DIM)),
        'lambda_vecs': nrm(ks[5], (DEPTH, 4, DA_QK_DIM), 0.1),
        'da_subln_g': gain(ks[6], (DEPTH, DA_V_DIM)),
        'rel_bias': nrm(ks[7], (REL_BUCKETS, DA_HEADS), 0.5),
        'gla_gate_w': nrm(ks[8], (DEPTH, GLA_GATE_RANK, GLA_HEADS * GLA_K_DIM), GLA_GATE_RANK ** -0.5),
        'gla_gate_b': nrm(ks[9], (DEPTH, GLA_HEADS * GLA_K_DIM), 0.1),
        'gla_norm_g': gain(ks[10], (DEPTH, GLA_V_DIM)),
        'pool_w': nrm(ks[11], (DEPTH, POOL_GROUPS, POOL_GROUP_DIM, POOL_GROUP_DIM), POOL_GROUP_DIM ** -0.5),
        'pool_scale': gain(ks[12], (DEPTH, POOL_WIDTH)),
        'w_out': nrm(ks[13], (DEPTH, MIX_WIDTH, D_MODEL), MIX_WIDTH ** -0.5),
        'ffn_norm_g': gain(ks[14], (DEPTH, D_MODEL)),
        'w_gate': nrm(ks[15], (DEPTH, D_MODEL, FFN_HIDDEN), D_MODEL ** -0.5),
        'w_up': nrm(ks[16], (DEPTH, D_MODEL, FFN_HIDDEN), D_MODEL ** -0.5),
        'w_down': nrm(ks[17], (DEPTH, FFN_HIDDEN, D_MODEL), FFN_HIDDEN ** -0.5),
    }


def reference(x, attn_norm_g, w_in, q_norm_g, k_norm_g, lambda_vecs, da_subln_g, rel_bias,
              gla_gate_w, gla_gate_b, gla_norm_g, pool_w, pool_scale, w_out,
              ffn_norm_g, w_gate, w_up, w_down):
    B, S, _ = x.shape
    split_points = np.cumsum(IN_SIZES)[:-1].tolist()
    bias_by_dist = rel_bias[t5_bucket(jnp.arange(S))]
    h = x
    for l in range(DEPTH):
        hn = rms_norm(h, attn_norm_g[l])
        proj = jnp.einsum('bsd,de->bse', hn, w_in[l])
        da_q, da_k, da_v, g_q, g_k, g_v, g_lr, g_r, pool_u = jnp.split(proj, split_points, axis=-1)

        q = rms_norm(da_q.reshape(B, S, DA_HEADS, 2, DA_QK_DIM), q_norm_g[l])
        k = rms_norm(da_k.reshape(B, S, DA_HEADS, 2, DA_QK_DIM), k_norm_g[l])
        v = da_v.reshape(B, S, DA_HEADS, DA_V_DIM)
        lv = lambda_vecs[l].astype(jnp.float32)
        lam_init = 0.8 - 0.6 * math.exp(-0.3 * l)
        lam = jnp.exp(jnp.sum(lv[0] * lv[1])) - jnp.exp(jnp.sum(lv[2] * lv[3])) + lam_init
        a_out = diff_attention(q, k, v, lam, bias_by_dist)
        a_out = rms_norm(a_out, da_subln_g[l]) * (1.0 - lam_init)
        a_out = a_out.reshape(B, S, DA_WIDTH).astype(h.dtype)

        z = jnp.einsum('bsr,rk->bsk', g_lr, gla_gate_w[l]) + gla_gate_b[l]
        log_a = jax.nn.log_sigmoid(z.astype(jnp.float32)) / GLA_GATE_NORM
        o = gla_chunked(g_q.reshape(B, S, GLA_HEADS, GLA_K_DIM),
                        g_k.reshape(B, S, GLA_HEADS, GLA_K_DIM),
                        g_v.reshape(B, S, GLA_HEADS, GLA_V_DIM),
                        log_a.reshape(B, S, GLA_HEADS, GLA_K_DIM))
        o = rms_norm(o, gla_norm_g[l]).reshape(B, S, GLA_WIDTH)
        b_out = (o * jax.nn.silu(g_r)).astype(h.dtype)

        c_out = multiscale_pool(pool_u, pool_w[l], pool_scale[l]).astype(h.dtype)

        mixed = jnp.concatenate([a_out, b_out, c_out], axis=-1)
        h = h + jnp.einsum('bse,ed->bsd', mixed, w_out[l])

        hn = rms_norm(h, ffn_norm_g[l])
        ff = jax.nn.silu(jnp.einsum('bsd,df->bsf', hn, w_gate[l])) * jnp.einsum('bsd,df->bsf', hn, w_up[l])
        h = h + jnp.einsum('bsf,fd->bsd', ff, w_down[l])
    return h
```

```cpp
#include <hip/hip_runtime.h>
#include <math.h>
#include <stdint.h>

namespace nv {
constexpr int D = 1024, NB = 16, S = 2048, T = NB * S, DEPTH = 2;
constexpr int NIN = 2576, FFN = 2816;
constexpr int OFF_DAQ = 0, OFF_DAK = 512, OFF_DAV = 1024, OFF_GQ = 1536, OFF_GK = 1664, OFF_GV = 1792, OFF_GLR = 2048, OFF_GR = 2064, OFF_PU = 2320;
constexpr float EPS = 1e-6f;

__device__ __forceinline__ float wave_sum(float v) {
#pragma unroll
    for (int o = 1; o < 64; o <<= 1) v += __shfl_xor(v, o);
    return v;
}
__device__ __forceinline__ float wave_max(float v) {
#pragma unroll
    for (int o = 1; o < 64; o <<= 1) v = fmaxf(v, __shfl_xor(v, o));
    return v;
}
__device__ __forceinline__ int t5_bucket(int d) {
    if (d < 16) return d;
    int large = 16 + (int)(logf((float)d / 16.f) / 2.0794415416798357f * 16.f);
    return large < 31 ? large : 31;
}

__global__ void __launch_bounds__(256) rms_rows(const float* __restrict__ x, const float* __restrict__ g, float* __restrict__ y, int rows) {
    const int row = blockIdx.x * 4 + (threadIdx.x >> 6), lane = threadIdx.x & 63;
    if (row >= rows) return;
    const float4* xr = (const float4*)(x + (size_t)row * D) + lane;
    float4 v[4]; float s = 0.f;
#pragma unroll
    for (int j = 0; j < 4; ++j) { v[j] = xr[64 * j]; s += v[j].x * v[j].x + v[j].y * v[j].y + v[j].z * v[j].z + v[j].w * v[j].w; }
    const float r = 1.0f / sqrtf(wave_sum(s) * (1.f / D) + EPS);
    float4* yr = (float4*)(y + (size_t)row * D) + lane; const float4* gr = (const float4*)g + lane;
#pragma unroll
    for (int j = 0; j < 4; ++j) { const float4 gg = gr[64 * j]; float4 o; o.x = v[j].x * r * gg.x; o.y = v[j].y * r * gg.y; o.z = v[j].z * r * gg.z; o.w = v[j].w * r * gg.w; yr[64 * j] = o; }
}

template <int MODE>
__global__ void __launch_bounds__(256) gemm_f32(const float* __restrict__ A, const float* __restrict__ Bm, const float* __restrict__ B2, const float* R, float* C, int M, int N, int K) {
    __shared__ float As[16][128 + 4];
    __shared__ float Bs[16][128 + 4];
    __shared__ float Bs2[MODE == 2 ? 16 : 1][128 + 4];
    const int tid = threadIdx.x, tx = tid & 15, ty = tid >> 4;
    const int m0 = blockIdx.y * 128, n0 = blockIdx.x * 128;
    float acc[8][8], acc2[MODE == 2 ? 8 : 1][8];
#pragma unroll
    for (int i = 0; i < 8; ++i)
#pragma unroll
        for (int j = 0; j < 8; ++j) { acc[i][j] = 0.f; if (MODE == 2) acc2[i][j] = 0.f; }
    for (int k0 = 0; k0 < K; k0 += 16) {
#pragma unroll
        for (int i = 0; i < 2; ++i) { const int idx = tid + i * 256, r = idx >> 2, kq = (idx & 3) * 4;
            const float4 a = *(const float4*)(A + (size_t)(m0 + r) * K + k0 + kq);
            As[kq + 0][r] = a.x; As[kq + 1][r] = a.y; As[kq + 2][r] = a.z; As[kq + 3][r] = a.w; }
#pragma unroll
        for (int i = 0; i < 2; ++i) { const int idx = tid + i * 256, kk = idx >> 5, c4 = (idx & 31) * 4;
            float4 b = make_float4(0.f, 0.f, 0.f, 0.f), b2 = b;
            if (n0 + c4 < N) { b = *(const float4*)(Bm + (size_t)(k0 + kk) * N + n0 + c4); if (MODE == 2) b2 = *(const float4*)(B2 + (size_t)(k0 + kk) * N + n0 + c4); }
            *(float4*)&Bs[kk][c4] = b; if (MODE == 2) *(float4*)&Bs2[kk][c4] = b2; }
        __syncthreads();
#pragma unroll
        for (int kk = 0; kk < 16; ++kk) {
            float a[8], b[8], b2[8];
            const float4 a0 = *(const float4*)&As[kk][ty * 4], a1 = *(const float4*)&As[kk][64 + ty * 4];
            a[0] = a0.x; a[1] = a0.y; a[2] = a0.z; a[3] = a0.w; a[4] = a1.x; a[5] = a1.y; a[6] = a1.z; a[7] = a1.w;
            const float4 b0 = *(const float4*)&Bs[kk][tx * 4], b1 = *(const float4*)&Bs[kk][64 + tx * 4];
            b[0] = b0.x; b[1] = b0.y; b[2] = b0.z; b[3] = b0.w; b[4] = b1.x; b[5] = b1.y; b[6] = b1.z; b[7] = b1.w;
            if (MODE == 2) { const float4 c0 = *(const float4*)&Bs2[kk][tx * 4], c1 = *(const float4*)&Bs2[kk][64 + tx * 4];
                b2[0] = c0.x; b2[1] = c0.y; b2[2] = c0.z; b2[3] = c0.w; b2[4] = c1.x; b2[5] = c1.y; b2[6] = c1.z; b2[7] = c1.w; }
#pragma unroll
            for (int i = 0; i < 8; ++i)
#pragma unroll
                for (int j = 0; j < 8; ++j) { acc[i][j] = fmaf(a[i], b[j], acc[i][j]); if (MODE == 2) acc2[i][j] = fmaf(a[i], b2[j], acc2[i][j]); }
        }
        __syncthreads();
    }
#pragma unroll
    for (int i = 0; i < 8; ++i) {
        const int r = m0 + (i >> 2) * 64 + ty * 4 + (i & 3);
#pragma unroll
        for (int jh = 0; jh < 2; ++jh) {
            const int c = n0 + jh * 64 + tx * 4;
            if (c < N) {
                float4 o;
                float v[4];
#pragma unroll
                for (int j = 0; j < 4; ++j) { float x = acc[i][jh * 4 + j];
                    if (MODE == 2) { const float u = acc2[i][jh * 4 + j]; x = x / (1.f + expf(-x)) * u; }
                    v[j] = x; }
                if (MODE == 1) { const float4 rr = *(const float4*)(R + (size_t)r * N + c); v[0] += rr.x; v[1] += rr.y; v[2] += rr.z; v[3] += rr.w; }
                o.x = v[0]; o.y = v[1]; o.z = v[2]; o.w = v[3];
                *(float4*)(C + (size_t)r * N + c) = o;
            }
        }
    }
}

__global__ void __launch_bounds__(256) qk_norm(float* proj, const float* __restrict__ qg, const float* __restrict__ kg) {
    const int w = blockIdx.x * 4 + (threadIdx.x >> 6), lane = threadIdx.x & 63;
    const int t = w >> 4, grp = w & 15;
    float* p = proj + (size_t)t * NIN + grp * 64 + lane;
    const float v = *p;
    const float r = 1.0f / sqrtf(wave_sum(v * v) * (1.f / 64.f) + EPS);
    *p = v * r * (grp < 8 ? qg[lane] : kg[lane]);
}

__device__ __forceinline__ float compute_lam(const float* lv, int layer, float& lam_init) {
    float s01 = 0.f, s23 = 0.f;
    for (int i = 0; i < 64; ++i) { s01 += lv[i] * lv[64 + i]; s23 += lv[128 + i] * lv[192 + i]; }
    lam_init = 0.8f - 0.6f * expf(-0.3f * (float)layer);
    return expf(s01) - expf(s23) + lam_init;
}

__global__ void __launch_bounds__(128) diff_attn(const float* __restrict__ proj, const float* __restrict__ rel_bias, const float* __restrict__ lv, const float* __restrict__ subg, float* mixed, int layer) {
    __shared__ float sc[2][2][S];
    __shared__ float biasd[S];
    const int wv = threadIdx.x >> 6, lane = threadIdx.x & 63;
    const int h = blockIdx.y, b = blockIdx.z, q = blockIdx.x * 2 + wv;
    for (int d = threadIdx.x; d < S; d += 128) biasd[d] = rel_bias[t5_bucket(d) * 4 + h];
    __syncthreads();
    float lam_init; const float lam = compute_lam(lv, layer, lam_init);
    const size_t rowq = (size_t)(b * S + q) * NIN;
    float lsum[2];
    for (int m = 0; m < 2; ++m) {
        float qreg[64];
        const float* qp = proj + rowq + OFF_DAQ + (h * 2 + m) * 64;
#pragma unroll
        for (int d = 0; d < 64; d += 4) { const float4 v = *(const float4*)(qp + d); qreg[d] = v.x; qreg[d + 1] = v.y; qreg[d + 2] = v.z; qreg[d + 3] = v.w; }
        float mx = -1e30f;
        for (int k = lane; k <= q; k += 64) {
            const float* kp = proj + (size_t)(b * S + k) * NIN + OFF_DAK + (h * 2 + m) * 64;
            float dot = 0.f;
#pragma unroll
            for (int d = 0; d < 64; d += 4) { const float4 v = *(const float4*)(kp + d); dot += qreg[d] * v.x + qreg[d + 1] * v.y + qreg[d + 2] * v.z + qreg[d + 3] * v.w; }
            const float s = dot * 0.125f + biasd[q - k];
            sc[wv][m][k] = s; mx = fmaxf(mx, s);
        }
        mx = wave_max(mx);
        float sum = 0.f;
        for (int k = lane; k <= q; k += 64) { const float p = expf(sc[wv][m][k] - mx); sc[wv][m][k] = p; sum += p; }
        lsum[m] = wave_sum(sum);
    }
    const float i0 = 1.f / lsum[0], i1 = lam / lsum[1];
    for (int k = lane; k <= q; k += 64) sc[wv][0][k] = sc[wv][0][k] * i0 - sc[wv][1][k] * i1;
    __builtin_amdgcn_s_waitcnt(0);
    __builtin_amdgcn_wave_barrier();
    float o0 = 0.f, o1 = 0.f;
    const float* vp = proj + (size_t)(b * S) * NIN + OFF_DAV + h * 128 + lane;
    for (int k = 0; k <= q; ++k) { const float w = sc[wv][0][k]; o0 = fmaf(w, vp[(size_t)k * NIN], o0); o1 = fmaf(w, vp[(size_t)k * NIN + 64], o1); }
    const float r = 1.0f / sqrtf(wave_sum(o0 * o0 + o1 * o1) * (1.f / 128.f) + EPS) * (1.f - lam_init);
    float* mp = mixed + (size_t)(b * S + q) * D + h * 128 + lane;
    mp[0] = o0 * r * subg[lane]; mp[64] = o1 * r * subg[lane + 64];
}

__global__ void __launch_bounds__(128) gla_loga(const float* __restrict__ proj, const float* __restrict__ gw, const float* __restrict__ gb, float* loga) {
    const int t = blockIdx.x, c = threadIdx.x;
    const float* lr = proj + (size_t)t * NIN + OFF_GLR;
    float z = gb[c];
#pragma unroll
    for (int r = 0; r < 16; ++r) z = fmaf(lr[r], gw[r * 128 + c], z);
    const float ls = fminf(z, 0.f) - log1pf(expf(-fabsf(z)));
    loga[(size_t)t * 128 + c] = ls * (1.f / 16.f);
}

__global__ void __launch_bounds__(64) gla_rec(const float* __restrict__ proj, const float* __restrict__ loga, const float* __restrict__ ng, float* mixed) {
    const int bh = blockIdx.x, b = bh >> 2, h = bh & 3, lane = threadIdx.x;
    float st[32];
#pragma unroll
    for (int d = 0; d < 32; ++d) st[d] = 0.f;
    const float scale = 0.17677669529663687f;
    for (int t = 0; t < S; ++t) {
        const size_t row = (size_t)(b * S + t);
        const float* pr = proj + row * NIN;
        const float v = pr[OFF_GV + h * 64 + lane];
        const float* qp = pr + OFF_GQ + h * 32; const float* kp = pr + OFF_GK + h * 32; const float* ap = loga + row * 128 + h * 32;
        float o = 0.f;
#pragma unroll
        for (int d = 0; d < 32; ++d) { st[d] = fmaf(expf(ap[d]), st[d], kp[d] * v); o = fmaf(qp[d], st[d], o); }
        o *= scale;
        const float r = 1.0f / sqrtf(wave_sum(o * o) * (1.f / 64.f) + EPS);
        const float gr = pr[OFF_GR + h * 64 + lane];
        mixed[row * D + 512 + h * 64 + lane] = o * r * ng[lane] * (gr / (1.f + expf(-gr)));
    }
}

__global__ void __launch_bounds__(256) pool_a(const float* __restrict__ proj, float* pooled) {
    const int t = blockIdx.x, c = threadIdx.x, g = c >> 6, win = 2 << g, s = t % S;
    const int cnt = (s + 1 < win) ? s + 1 : win;
    float sum = 0.f;
    for (int j = 0; j < cnt; ++j) sum += proj[(size_t)(t - j) * NIN + OFF_PU + c];
    pooled[(size_t)t * 256 + c] = sum / (float)cnt - proj[(size_t)t * NIN + OFF_PU + c];
}
__global__ void __launch_bounds__(256) pool_b(const float* __restrict__ pooled, const float* __restrict__ pw, const float* __restrict__ ps, float* mixed) {
    __shared__ float pl[256];
    const int t = blockIdx.x, c = threadIdx.x, g = c >> 6, dd = c & 63;
    pl[c] = pooled[(size_t)t * 256 + c];
    __syncthreads();
    float acc = 0.f;
    for (int i = 0; i < 64; ++i) acc = fmaf(pl[g * 64 + i], pw[(g * 64 + i) * 64 + dd], acc);
    mixed[(size_t)t * D + 768 + c] = acc * ps[c];
}
}

extern "C" void kernel_launch(void* const* d_in, const int* in_sizes, int n_in, void* d_out, int out_size, void* d_ws, size_t ws_size, hipStream_t stream) {
    using namespace nv;
    const float* x = (const float*)d_in[0];
    const float* attn_norm_g = (const float*)d_in[1];
    const float* w_in = (const float*)d_in[2];
    const float* q_norm_g = (const float*)d_in[3];
    const float* k_norm_g = (const float*)d_in[4];
    const float* lambda_vecs = (const float*)d_in[5];
    const float* da_subln_g = (const float*)d_in[6];
    const float* rel_bias = (const float*)d_in[7];
    const float* gla_gate_w = (const float*)d_in[8];
    const float* gla_gate_b = (const float*)d_in[9];
    const float* gla_norm_g = (const float*)d_in[10];
    const float* pool_w = (const float*)d_in[11];
    const float* pool_scale = (const float*)d_in[12];
    const float* w_out = (const float*)d_in[13];
    const float* ffn_norm_g = (const float*)d_in[14];
    const float* w_gate = (const float*)d_in[15];
    const float* w_up = (const float*)d_in[16];
    const float* w_down = (const float*)d_in[17];
    float* out = (float*)d_out;
    char* ws = (char*)d_ws;
    const size_t MB = 1u << 20;
    float* HN = (float*)(ws);
    float* PROJ = (float*)(ws + 128 * MB);
    float* LOGA = (float*)(ws + 450 * MB);
    float* POOLED = (float*)(ws + 466 * MB);
    float* MIXED = HN;
    float* FF = PROJ;
    if (ws_size < 512 * MB) return;
    for (int l = 0; l < DEPTH; ++l) {
        const float* hin = (l == 0) ? x : out;
        rms_rows<<<T / 4, 256, 0, stream>>>(hin, attn_norm_g + l * D, HN, T);
        gemm_f32<0><<<dim3((NIN + 127) / 128, T / 128), 256, 0, stream>>>(HN, w_in + (size_t)l * D * NIN, nullptr, nullptr, PROJ, T, NIN, D);
        qk_norm<<<T * 16 / 4, 256, 0, stream>>>(PROJ, q_norm_g + l * 64, k_norm_g + l * 64);
        diff_attn<<<dim3(S / 2, 4, NB), 128, 0, stream>>>(PROJ, rel_bias, lambda_vecs + l * 256, da_subln_g + l * 128, MIXED, l);
        gla_loga<<<T, 128, 0, stream>>>(PROJ, gla_gate_w + l * 16 * 128, gla_gate_b + l * 128, LOGA);
        gla_rec<<<NB * 4, 64, 0, stream>>>(PROJ, LOGA, gla_norm_g + l * 64, MIXED);
        pool_a<<<T, 256, 0, stream>>>(PROJ, POOLED);
        pool_b<<<T, 256, 0, stream>>>(POOLED, pool_w + l * 4 * 64 * 64, pool_scale + l * 256, MIXED);
        gemm_f32<1><<<dim3(D / 128, T / 128), 256, 0, stream>>>(MIXED, w_out + (size_t)l * D * D, nullptr, hin, out, T, D, D);
        rms_rows<<<T / 4, 256, 0, stream>>>(out, ffn_norm_g + l * D, HN, T);
        gemm_f32<2><<<dim3(FFN / 128, T / 128), 256, 0, stream>>>(HN, w_gate + (size_t)l * D * FFN, w_up + (size_t)l * D * FFN, nullptr, FF, T, FFN, D);
        gemm_f32<1><<<dim3(D / 128, T / 128), 256, 0, stream>>>(FF, w_down + (size_t)l * FFN * D, nullptr, out, out, T, D, FFN);
    }
}
```

```cpp
#include <hip/hip_runtime.h>
#include <hip/hip_bf16.h>
#include <cstdio>
#include <cstdint>
#include <cmath>
namespace pg8 {
#define PG8_LAS __attribute__((address_space(3)))
typedef unsigned short bf16_t;
typedef short bf16x8 __attribute__((ext_vector_type(8)));
typedef float f32x4 __attribute__((ext_vector_type(4)));
typedef unsigned u32x4 __attribute__((ext_vector_type(4)));
constexpr int BM = 256, BK = 64, HALF = 128, HTB = HALF * BK * 2  , STAGE_BYTES = 8 * HTB, NXCD = 8, WGM = 8;

__host__ __device__ __forceinline__ int lds_byte(int r, int c) { const int st = (r >> 4) * 2 + (c >> 5), rr = r & 15, cc = c & 31, ob = rr * 64 + cc * 2; return st * 1024 + (ob ^ (((ob >> 9) & 1) << 5)); }
__host__ __device__ __forceinline__ void stage_rc(int b, int& R, int& C) { const int st = b / 1024, sb = b % 1024, swz = sb ^ (((sb >> 9) & 1) << 5); R = (st >> 1) * 16 + swz / 64; C = (st & 1) * 32 + (swz % 64) / 2; }
__host__ __device__ __forceinline__ int perm32(int rho) { const int n = rho >> 4, i = rho & 15; return 8 * (i >> 2) + 4 * n + (i & 3); }

struct Unit { int pm, pn, ui; };
struct Gemm { const bf16_t* A; const bf16_t* Bt; int M, N, K; };

struct StaticOrder {
    int nM, nN, nwg, G, c, wgm;
    __host__ __device__ void init(int M, int N, int G_, int c_, int wgm_ = 4) { nM = M / BM; nN = N / BM; nwg = nM * nN; G = G_; c = c_; wgm = wgm_; }
    __host__ __device__ bool next(int i, Unit& u) const {
        const long L = (long)i * G + c; if (L >= nwg) return false;
        int wgid = (int)L; { const int q = nwg / NXCD, r = nwg % NXCD, xcd = wgid % NXCD, off = wgid / NXCD; wgid = (xcd < r ? xcd * (q + 1) : r * (q + 1) + (xcd - r) * q) + off; }
        const int nig = wgm * nN, gid = wgid / nig, fm = gid * wgm, gsz = (nM - fm) < wgm ? (nM - fm) : wgm;
        u.pm = fm + ((wgid % nig) % gsz); u.pn = (wgid % nig) / gsz; u.ui = i; return true;
    }
    __device__ __forceinline__ void a_ready(const Unit&) const {}
    __device__ __forceinline__ void done(const Unit&) const {}
};
__device__ __forceinline__ unsigned cvt_pk_bf16(float lo, float hi) { unsigned r; asm volatile("v_cvt_pk_bf16_f32 %0, %1, %2" : "=v"(r) : "v"(lo), "v"(hi)); return r; }
typedef unsigned u32x2 __attribute__((ext_vector_type(2)));
constexpr float MK_EPS = 1e-6f;
template <class Sched> __device__ __forceinline__ void rs_table_fill(PG8_LAS float* rst, const float* rowsq, const Sched& S, int tid) {
    for (int idx = tid; ; idx += 512) { Unit u; if (!S.next(idx >> 8, u)) break;
        const f32x4* p = (const f32x4*)(rowsq + (size_t)(u.pm * BM + (idx & 255)) * 16);
        const f32x4 a = p[0], b = p[1], c = p[2], d = p[3]; const f32x4 t = (a + b) + (c + d);
        rst[idx] = __builtin_amdgcn_rsqf(((t[0] + t[1]) + (t[2] + t[3])) * (1.0f / 1024.0f) + MK_EPS); }
    __syncthreads();
}
struct EpiProj {
    static constexpr bool PERM = true, AFTER_DRAIN = false;
    const PG8_LAS float* rst; bf16_t *Q, *K, *V, *G4, *GLR; const float* qg; const float* kg; float c2;
    __device__ __forceinline__ void operator()(const f32x4 (&acc)[2][2][4][2], const Unit& u, int wr, int wc, int fr, int fq) const {
        const int row0 = u.pm * BM + wr * 64 + fr; const int pn = u.pn;
        float rs[2][4]; const PG8_LAS float* rsp = rst + u.ui * BM + wr * 64 + fr;
#pragma unroll
        for (int ai = 0; ai < 2; ++ai)
#pragma unroll
            for (int m = 0; m < 4; ++m) rs[ai][m] = rsp[ai * HALF + m * 16];
        if (pn < 4) {
            const int g = pn * 4 + wc; const bool isq = g < 8; const float* gain = isq ? qg : kg; const float sc = isq ? c2 : 1.0f;
            bf16_t* dst = (isq ? Q : K) + (g & 7) * 64 + 8 * fq;
            f32x4 gv[2][2];
#pragma unroll
            for (int bj = 0; bj < 2; ++bj)
#pragma unroll
                for (int n = 0; n < 2; ++n) gv[bj][n] = *(const f32x4*)(gain + 32 * bj + 8 * fq + 4 * n) * sc;
#pragma unroll
            for (int ai = 0; ai < 2; ++ai)
#pragma unroll
                for (int m = 0; m < 4; ++m) {
                    const float r = rs[ai][m]; f32x4 v[2][2]; float ss = 0.f;
#pragma unroll
                    for (int bj = 0; bj < 2; ++bj)
#pragma unroll
                        for (int n = 0; n < 2; ++n) { v[bj][n] = acc[ai][bj][m][n] * r; const f32x4 q = v[bj][n] * v[bj][n]; ss += (q[0] + q[1]) + (q[2] + q[3]); }
                    ss += __shfl_xor(ss, 16); ss += __shfl_xor(ss, 32);
                    const float rn = __builtin_amdgcn_rsqf(ss * (1.0f / 64.0f) + MK_EPS);
                    bf16_t* rowp = dst + (size_t)(row0 + ai * HALF + m * 16) * 512;
#pragma unroll
                    for (int bj = 0; bj < 2; ++bj) { const f32x4 a = v[bj][0] * rn * gv[bj][0], b = v[bj][1] * rn * gv[bj][1];
                        u32x4 w; w.x = cvt_pk_bf16(a[0], a[1]); w.y = cvt_pk_bf16(a[2], a[3]); w.z = cvt_pk_bf16(b[0], b[1]); w.w = cvt_pk_bf16(b[2], b[3]);
                        *(u32x4*)(rowp + 32 * bj) = w; }
                }
        } else if (pn < 10) {
            bf16_t* dst; int pitch;
            if (pn < 6) { dst = V + (pn - 4) * 256; pitch = 512; } else { dst = G4 + (size_t)(pn - 6) * ((size_t)8 << 20); pitch = 256; }
            dst += 64 * wc + 8 * fq;
#pragma unroll
            for (int ai = 0; ai < 2; ++ai)
#pragma unroll
                for (int m = 0; m < 4; ++m) {
                    const float r = rs[ai][m]; bf16_t* rowp = dst + (size_t)(row0 + ai * HALF + m * 16) * pitch;
#pragma unroll
                    for (int bj = 0; bj < 2; ++bj) { const f32x4 a = acc[ai][bj][m][0] * r, b = acc[ai][bj][m][1] * r;
                        u32x4 w; w.x = cvt_pk_bf16(a[0], a[1]); w.y = cvt_pk_bf16(a[2], a[3]); w.z = cvt_pk_bf16(b[0], b[1]); w.w = cvt_pk_bf16(b[2], b[3]);
                        *(u32x4*)(rowp + 32 * bj) = w; }
                }
        } else {
            if (wc == 0 && fq < 2) {
#pragma unroll
                for (int ai = 0; ai < 2; ++ai)
#pragma unroll
                    for (int m = 0; m < 4; ++m) { const float r = rs[ai][m]; const f32x4 a = acc[ai][0][m][0] * r, b = acc[ai][0][m][1] * r;
                        u32x4 w; w.x = cvt_pk_bf16(a[0], a[1]); w.y = cvt_pk_bf16(a[2], a[3]); w.z = cvt_pk_bf16(b[0], b[1]); w.w = cvt_pk_bf16(b[2], b[3]);
                        *(u32x4*)(GLR + (size_t)(row0 + ai * HALF + m * 16) * 16 + 8 * fq) = w; }
            }
        }
    }
};
template <bool FINAL> struct EpiRes {
    static constexpr bool PERM = false, AFTER_DRAIN = false;
    float* out; bf16_t* HB; float* rowsq_out;
    __device__ __forceinline__ void operator()(const f32x4 (&acc)[2][2][4][2], const Unit& u, int wr, int wc, int fr, int fq) const {
        const int row0 = u.pm * BM + wr * 64 + fr, col0 = u.pn * BM + wc * 32 + 4 * fq;
        u32x2 rr[2][4][2][2];
#pragma unroll
        for (int ai = 0; ai < 2; ++ai)
#pragma unroll
            for (int m = 0; m < 4; ++m) { const size_t off = (size_t)(row0 + ai * HALF + m * 16) * 1024 + col0;
#pragma unroll
                for (int bj = 0; bj < 2; ++bj)
#pragma unroll
                    for (int n = 0; n < 2; ++n) rr[ai][m][bj][n] = *(const u32x2*)(HB + off + bj * HALF + n * 16); }
#pragma unroll
        for (int ai = 0; ai < 2; ++ai)
#pragma unroll
            for (int m = 0; m < 4; ++m) {
                const int row = row0 + ai * HALF + m * 16; const size_t off = (size_t)row * 1024 + col0; float ss = 0.f;
#pragma unroll
                for (int bj = 0; bj < 2; ++bj)
#pragma unroll
                    for (int n = 0; n < 2; ++n) { const u32x2 w0 = rr[ai][m][bj][n];
                        const f32x4 res = {__builtin_bit_cast(float, w0.x << 16), __builtin_bit_cast(float, w0.x & 0xffff0000u), __builtin_bit_cast(float, w0.y << 16), __builtin_bit_cast(float, w0.y & 0xffff0000u)};
                        const f32x4 h = res + acc[ai][bj][m][n];
                        if (FINAL) *(f32x4*)(out + off + bj * HALF + n * 16) = h;
                        else { const f32x4 q = h * h; ss += (q[0] + q[1]) + (q[2] + q[3]);
                            u32x2 w; w.x = cvt_pk_bf16(h[0], h[1]); w.y = cvt_pk_bf16(h[2], h[3]); *(u32x2*)(HB + off + bj * HALF + n * 16) = w; } }
                if (!FINAL) { ss += __shfl_xor(ss, 16); ss += __shfl_xor(ss, 32); if (fq == 0) rowsq_out[(size_t)row * 16 + u.pn * 4 + wc] = ss; }
            }
    }
};
struct EpiGU {
    static constexpr bool PERM = true, AFTER_DRAIN = false;
    const PG8_LAS float* rst; bf16_t* FF;
    __device__ __forceinline__ void operator()(const f32x4 (&acc)[2][2][4][2], const Unit& u, int wr, int wc, int fr, int fq) const {
        const int row0 = u.pm * BM + wr * 64 + fr, col0 = u.pn * 128 + wc * 32 + 8 * fq;
        float rs[2][4]; const PG8_LAS float* rsp = rst + u.ui * BM + wr * 64 + fr;
#pragma unroll
        for (int ai = 0; ai < 2; ++ai)
#pragma unroll
            for (int m = 0; m < 4; ++m) rs[ai][m] = rsp[ai * HALF + m * 16];
#pragma unroll
        for (int ai = 0; ai < 2; ++ai)
#pragma unroll
            for (int m = 0; m < 4; ++m) {
                const int row = row0 + ai * HALF + m * 16; const float r = rs[ai][m];
                const float rneg = r * -1.4426950408889634f, ir2 = __builtin_amdgcn_rcpf(r * r);
                f32x4 f[2];
#pragma unroll
                for (int n = 0; n < 2; ++n) { const f32x4 G = acc[ai][0][m][n], U = acc[ai][1][m][n]; const f32x4 a = G * rneg;
                    const f32x4 e = {__builtin_amdgcn_exp2f(a[0]), __builtin_amdgcn_exp2f(a[1]), __builtin_amdgcn_exp2f(a[2]), __builtin_amdgcn_exp2f(a[3])};
                    const f32x4 d = e * ir2 + ir2;
                    const f32x4 rc = {__builtin_amdgcn_rcpf(d[0]), __builtin_amdgcn_rcpf(d[1]), __builtin_amdgcn_rcpf(d[2]), __builtin_amdgcn_rcpf(d[3])};
                    f[n] = (G * U) * rc; }
                u32x4 w; w.x = cvt_pk_bf16(f[0][0], f[0][1]); w.y = cvt_pk_bf16(f[0][2], f[0][3]); w.z = cvt_pk_bf16(f[1][0], f[1][1]); w.w = cvt_pk_bf16(f[1][2], f[1][3]);
                *(u32x4*)(FF + (size_t)row * 2816 + col0) = w;
            }
    }
};

template <class Epi, class Sched, bool ALIGN_EPI = false, bool SP2 = false>
__device__ __forceinline__ void gemm_phase(PG8_LAS unsigned char* lds, const Gemm g, const Sched& S, const Epi& E) {
    int tid_l = threadIdx.x; asm volatile("" : "+v"(tid_l)); const int tid = tid_l, wid = __builtin_amdgcn_readfirstlane(tid >> 6), lane = tid & 63, wr = wid >> 2, wc = wid & 3, fr = lane & 15, fq = lane >> 4;
    const int K = g.K, nt = K / BK;
    unsigned voffA[2], voffB[2];
#pragma unroll
    for (int i = 0; i < 2; ++i) { int R, C; stage_rc(tid * 16 + i * 8192, R, C); const int Rb = Epi::PERM ? ((R & ~31) + perm32(R & 31)) : R;
        voffA[i] = (unsigned)(R * K + C) * 2u; voffB[i] = (unsigned)(Rb * K + C) * 2u; }
    const size_t kstep = (size_t)(BK * 2);
    const size_t hstep = (size_t)HALF * K * 2;
    const size_t tstep = 2 * hstep;
    const unsigned ldsw = (unsigned)wid * 1024u;
    const int aoff = lds_byte(wr * 64 + fr, fq * 8), boff = lds_byte(wc * 32 + fr, fq * 8);
#define PG8_SA(b, h) (((b) * 2 + (h)) * HTB)
#define PG8_SB(b, h) ((4 + (b) * 2 + (h)) * HTB)
#define PG8_STAGE(bufoff, gbase, voff) do { _Pragma("unroll") for (int _i = 0; _i < 2; ++_i) \
        __builtin_amdgcn_global_load_lds((const unsigned*)((const char*)(gbase) + (voff)[_i]), (PG8_LAS unsigned*)(lds + (bufoff) + ldsw + _i * 8192), 16, 0, 0); } while (0)
#define PG8_LDA(dst, b, h) do { _Pragma("unroll") for (int m = 0; m < 4; ++m) _Pragma("unroll") for (int k = 0; k < 2; ++k) dst[m][k] = *(const PG8_LAS bf16x8*)(lds + PG8_SA(b, h) + aoff + m * 2048 + k * 1024); } while (0)
#define PG8_LDB(dst, b, h) do { _Pragma("unroll") for (int n = 0; n < 2; ++n) _Pragma("unroll") for (int k = 0; k < 2; ++k) dst[n][k] = *(const PG8_LAS bf16x8*)(lds + PG8_SB(b, h) + boff + n * 2048 + k * 1024); } while (0)
#define PG8_MMA(ai, bj, At, Bt) do { __builtin_amdgcn_s_setprio(1); _Pragma("unroll") for (int m = 0; m < 4; ++m) _Pragma("unroll") for (int n = 0; n < 2; ++n) _Pragma("unroll") for (int k = 0; k < 2; ++k) \
        acc[ai][bj][m][n] = __builtin_amdgcn_mfma_f32_16x16x32_bf16(Bt[n][k], At[m][k], acc[ai][bj][m][n], 0, 0, 0); __builtin_amdgcn_s_setprio(0); } while (0)
#define PG8_WAIT_V(n) asm volatile("s_waitcnt vmcnt(" #n ")" ::: "memory")
#define PG8_WAIT_L(n) asm volatile("s_waitcnt lgkmcnt(" #n ")" ::: "memory")
#define PG8_BAR __builtin_amdgcn_s_barrier()
#define PG8_SCHED __builtin_amdgcn_sched_barrier(0)
    Unit cur, nxt; int ui = 0;
    if (!S.next(0, cur)) return;
    f32x4 acc[2][2][4][2];
#pragma unroll
    for (int a = 0; a < 2; ++a)
#pragma unroll
        for (int b = 0; b < 2; ++b)
#pragma unroll
            for (int m = 0; m < 4; ++m)
#pragma unroll
                for (int n = 0; n < 2; ++n) acc[a][b][m][n] = (f32x4){0.f, 0.f, 0.f, 0.f};
    bf16x8 At[4][2], B0[2][2], B1[2][2];
    const char* cA = (const char*)g.A + (size_t)cur.pm * tstep; const char* cB = (const char*)g.Bt + (size_t)cur.pn * tstep;
    S.a_ready(cur);
    if constexpr (SP2) {
        PG8_STAGE(PG8_SB(0, 0), cB, voffB); PG8_STAGE(PG8_SB(0, 1), cB + hstep, voffB); PG8_STAGE(PG8_SA(0, 0), cA, voffA); PG8_STAGE(PG8_SA(0, 1), cA + hstep, voffA);
        if (wr == 1) PG8_BAR;
        PG8_WAIT_V(2); PG8_BAR;
        PG8_STAGE(PG8_SB(1, 0), cB + kstep, voffB); PG8_STAGE(PG8_SA(1, 0), cA + kstep, voffA); PG8_STAGE(PG8_SB(1, 1), cB + hstep + kstep, voffB);
        PG8_WAIT_V(6); PG8_BAR;
    } else {
        PG8_STAGE(PG8_SB(0, 0), cB, voffB); PG8_STAGE(PG8_SA(0, 0), cA, voffA); PG8_STAGE(PG8_SB(0, 1), cB + hstep, voffB); PG8_STAGE(PG8_SA(0, 1), cA + hstep, voffA);
        if (wr == 1) PG8_BAR;
        PG8_WAIT_V(4); PG8_BAR;
        PG8_STAGE(PG8_SB(1, 0), cB + kstep, voffB); PG8_STAGE(PG8_SA(1, 0), cA + kstep, voffA); PG8_STAGE(PG8_SB(1, 1), cB + hstep + kstep, voffB);
        PG8_WAIT_V(6); PG8_BAR;
    }
    for (;;) {
        const bool has_next = S.next(ui + 1, nxt);
        const char* nA = has_next ? (const char*)g.A + (size_t)nxt.pm * tstep : cA; const char* nB = has_next ? (const char*)g.Bt + (size_t)nxt.pn * tstep : cB;
        for (int t = 0; t < nt; t += 2) {
            const bool last = (t == nt - 2);
            const char* a1 = cA + (size_t)(t + 1) * kstep;
            const char* a2 = last ? nA : cA + (size_t)(t + 2) * kstep; const char* b2 = last ? nB : cB + (size_t)(t + 2) * kstep;
            const char* a3 = a2 + kstep; const char* b3 = b2 + kstep;
            if (last && has_next) S.a_ready(nxt);
            if constexpr (SP2) {
            PG8_LDB(B0, 0, 0); PG8_LDB(B1, 0, 1); PG8_SCHED; PG8_LDA(At, 0, 0); PG8_STAGE(PG8_SA(1, 1), a1 + hstep, voffA);
            PG8_WAIT_V(8); PG8_WAIT_L(0); PG8_BAR; PG8_MMA(0, 0, At, B0); PG8_MMA(0, 1, At, B1); PG8_BAR; PG8_SCHED;
            PG8_LDA(At, 0, 1); PG8_STAGE(PG8_SB(0, 0), b2, voffB); PG8_STAGE(PG8_SB(0, 1), b2 + hstep, voffB); PG8_STAGE(PG8_SA(0, 0), a2, voffA);
            PG8_WAIT_V(8); PG8_WAIT_L(0); PG8_BAR; PG8_MMA(1, 0, At, B0); PG8_MMA(1, 1, At, B1); PG8_BAR; PG8_SCHED;
            PG8_LDB(B0, 1, 0); PG8_LDB(B1, 1, 1); PG8_SCHED; PG8_LDA(At, 1, 0); PG8_STAGE(PG8_SA(0, 1), a2 + hstep, voffA);
            PG8_WAIT_V(8); PG8_WAIT_L(0); PG8_BAR; PG8_MMA(0, 0, At, B0); PG8_MMA(0, 1, At, B1); PG8_BAR; PG8_SCHED;
            PG8_LDA(At, 1, 1); PG8_STAGE(PG8_SB(1, 0), b3, voffB); PG8_STAGE(PG8_SB(1, 1), b3 + hstep, voffB); PG8_STAGE(PG8_SA(1, 0), a3, voffA);
            PG8_WAIT_V(8); PG8_WAIT_L(0); PG8_BAR; PG8_MMA(1, 0, At, B0); PG8_MMA(1, 1, At, B1); PG8_BAR; PG8_SCHED;
            } else {
            PG8_LDB(B0, 0, 0); PG8_SCHED; PG8_LDA(At, 0, 0); PG8_STAGE(PG8_SA(1, 1), a1 + hstep, voffA);
            PG8_WAIT_L(8); PG8_BAR; PG8_WAIT_L(0); PG8_MMA(0, 0, At, B0); PG8_BAR; PG8_SCHED;
            PG8_LDB(B1, 0, 1); PG8_STAGE(PG8_SB(0, 0), b2, voffB);
            PG8_BAR; PG8_WAIT_L(0); PG8_MMA(0, 1, At, B1); PG8_BAR;
            PG8_LDA(At, 0, 1); PG8_STAGE(PG8_SA(0, 0), a2, voffA);
            PG8_BAR; PG8_WAIT_L(0); PG8_MMA(1, 0, At, B0); PG8_BAR; PG8_SCHED;
            PG8_STAGE(PG8_SB(0, 1), b2 + hstep, voffB);
            PG8_WAIT_V(6); PG8_BAR; PG8_MMA(1, 1, At, B1); PG8_BAR;
            PG8_LDB(B0, 1, 0); PG8_SCHED; PG8_LDA(At, 1, 0); PG8_STAGE(PG8_SA(0, 1), a2 + hstep, voffA);
            PG8_WAIT_L(8); PG8_BAR; PG8_WAIT_L(0); PG8_MMA(0, 0, At, B0); PG8_BAR; PG8_SCHED;
            PG8_LDB(B1, 1, 1); PG8_STAGE(PG8_SB(1, 0), b3, voffB);
            PG8_BAR; PG8_WAIT_L(0); PG8_MMA(0, 1, At, B1); PG8_BAR;
            PG8_LDA(At, 1, 1); PG8_STAGE(PG8_SA(1, 0), a3, voffA);
            PG8_BAR; PG8_WAIT_L(0); PG8_MMA(1, 0, At, B0); PG8_BAR; PG8_SCHED;
            PG8_STAGE(PG8_SB(1, 1), b3 + hstep, voffB);
            PG8_WAIT_V(6); PG8_BAR; PG8_MMA(1, 1, At, B1); PG8_BAR;
            }
        }
        if constexpr (ALIGN_EPI) { if (wr == 0) PG8_BAR; }
        if constexpr (!Epi::AFTER_DRAIN) { E(acc, cur, wr, wc, fr, fq); S.done(cur); }
        if (!has_next) break;
#pragma unroll
        for (int a = 0; a < 2; ++a)
#pragma unroll
            for (int b = 0; b < 2; ++b)
#pragma unroll
                for (int m = 0; m < 4; ++m)
#pragma unroll
                    for (int n = 0; n < 2; ++n) acc[a][b][m][n] = (f32x4){0.f, 0.f, 0.f, 0.f};
        cur = nxt; cA = nA; cB = nB; ++ui;
        if constexpr (ALIGN_EPI) { if (wr == 1) PG8_BAR; }
    }
    PG8_WAIT_V(0);
    if constexpr (!ALIGN_EPI) { if (wr == 0) PG8_BAR; }
    PG8_BAR;
    if constexpr (Epi::AFTER_DRAIN) { E.fused(acc, cur, wr, wc, fr, fq, lds, wid, lane); S.done(cur); }
#undef PG8_SA
#undef PG8_SB
#undef PG8_STAGE
#undef PG8_LDA
#undef PG8_LDB
#undef PG8_MMA
#undef PG8_WAIT_V
#undef PG8_WAIT_L
#undef PG8_BAR
#undef PG8_SCHED
}
}
#include <hip/hip_bf16.h>
namespace attn_body {
using bf16=__hip_bfloat16;
using bf16x8=__attribute__((ext_vector_type(8)))short;
using s16x4=__attribute__((ext_vector_type(4)))short;
using f32x16=__attribute__((ext_vector_type(16)))float;
using u32x4=__attribute__((ext_vector_type(4)))unsigned;
constexpr int BATCH=16,SEQ=2048,D=64,QP=512,KP=512,VP=512,OP=1024;
constexpr int NW=8,QBLK=32,QB=QBLK*NW,KVBLK=64,NQB=SEQ/QB;
constexpr int ATTN_UNIT_ROWS=QB;
__device__ __forceinline__ int crow(int r,int hi){return (r&3)+8*(r>>2)+4*hi;}
#define SBAR() __builtin_amdgcn_sched_barrier(0)
__device__ __forceinline__ void cmask(f32x16&p0,f32x16&p1,int jb,int qrel,int hi){
  const float NEG=-INFINITY; int kb=64*jb+4*hi;
  #pragma unroll
  for(int r=0;r<16;++r){int kv=kb+(r&3)+8*(r>>2); if(kv>qrel)p0[r]=NEG; if(kv+32>qrel)p1[r]=NEG;}
}

__device__ __forceinline__ void bmask(f32x16&p0,f32x16&p1,int jb6,int qrel,int hi,const __attribute__((address_space(3))) float*rt){
  const __attribute__((address_space(3))) float*p=rt+(255-qrel+64*jb6+4*hi);
  #pragma unroll
  for(int r=0;r<16;++r){const int o=(r&3)+8*(r>>2); p0[r]+=p[o]; p1[r]+=p[o+32];}
}
constexpr int NSLOT=3, SLOTB=8192;
constexpr int LDS_K=0, LDS_V=NSLOT*SLOTB, LDS_WS=2*NSLOT*SLOTB, LDS_OST=LDS_WS+NW*64*4, LDS_BYTES=LDS_OST+NW*4096;
constexpr float C2=0.125f*1.4426950408889634f;
__device__ __forceinline__ void glds16(const void*gsrc,unsigned lds_dst){unsigned keep;
  asm volatile("s_mov_b32 %0, m0\n\ts_mov_b32 m0, %2\n\ts_nop 0\n\tglobal_load_lds_dwordx4 %1, off\n\ts_mov_b32 m0, %0":"=&s"(keep):"v"(gsrc),"s"(lds_dst):"memory");}
__device__ __forceinline__ float max3f(float a,float b,float c){float r;asm("v_max3_f32 %0, %1, %2, %3":"=v"(r):"v"(a),"v"(b),"v"(c));return r;}
__device__ __forceinline__ float max2f(float a,float b){float r;asm("v_max_f32_e32 %0, %1, %2":"=v"(r):"v"(a),"v"(b));return r;}
__device__ __forceinline__ float fadd_s(float a,float b){float r;asm("v_add_f32_e32 %0, %1, %2":"=v"(r):"v"(a),"v"(b));return r;}
__device__ __forceinline__ float fsub_s(float a,float b){float r;asm("v_sub_f32_e32 %0, %1, %2":"=v"(r):"v"(a),"v"(b));return r;}
typedef float f32x2_t __attribute__((ext_vector_type(2))); typedef __bf16 bf16x2_t __attribute__((ext_vector_type(2)));
__device__ __forceinline__ unsigned cvtpk_s(float lo,float hi){f32x2_t v={lo,hi};bf16x2_t b=__builtin_convertvector(v,bf16x2_t);return __builtin_bit_cast(unsigned,b);}
#define WAIT_BAR(N) asm volatile("s_waitcnt vmcnt(" #N ") lgkmcnt(0)\n\ts_barrier":::"memory")

__device__ __forceinline__ void qkt(f32x16&p0,f32x16&p1,const char*Kslot,const bf16x8*qr,const f32x16&negm,int r32,int hi){
  const char*kb=Kslot+hi*1024+r32*16;
  #pragma unroll
  for(int d0=0;d0<4;++d0){
    const bf16x8 b0=*reinterpret_cast<const bf16x8*>(kb+d0*2048);
    const bf16x8 b1=*reinterpret_cast<const bf16x8*>(kb+d0*2048+512);
    if(d0==0){p0=__builtin_amdgcn_mfma_f32_32x32x16_bf16(b0,qr[0],negm,0,0,0);p1=__builtin_amdgcn_mfma_f32_32x32x16_bf16(b1,qr[0],negm,0,0,0);}
    else{p0=__builtin_amdgcn_mfma_f32_32x32x16_bf16(b0,qr[d0],p0,0,0,0);p1=__builtin_amdgcn_mfma_f32_32x32x16_bf16(b1,qr[d0],p1,0,0,0);}}
}
typedef __attribute__((address_space(3))) const char* lds_cptr;
typedef short v4i16_t __attribute__((ext_vector_type(4)));
__device__ __forceinline__ void kload8(bf16x8*kf,lds_cptr kp){
  kf[0]=*(const __attribute__((address_space(3))) bf16x8*)(kp);      kf[1]=*(const __attribute__((address_space(3))) bf16x8*)(kp+512);
  kf[2]=*(const __attribute__((address_space(3))) bf16x8*)(kp+2048); kf[3]=*(const __attribute__((address_space(3))) bf16x8*)(kp+2560);
  kf[4]=*(const __attribute__((address_space(3))) bf16x8*)(kp+4096); kf[5]=*(const __attribute__((address_space(3))) bf16x8*)(kp+4608);
  kf[6]=*(const __attribute__((address_space(3))) bf16x8*)(kp+6144); kf[7]=*(const __attribute__((address_space(3))) bf16x8*)(kp+6656);
}
__device__ __forceinline__ void kload2(bf16x8*kf,lds_cptr kp,int j){ kf[2*j]=*(const __attribute__((address_space(3))) bf16x8*)(kp+j*2048); kf[2*j+1]=*(const __attribute__((address_space(3))) bf16x8*)(kp+j*2048+512); }
__device__ __forceinline__ s16x4 vtr(lds_cptr p){ return __builtin_bit_cast(s16x4,__builtin_amdgcn_ds_read_tr16_b64_v4i16((__attribute__((address_space(3))) v4i16_t*)p)); }
__device__ __forceinline__ float rowmax(const f32x16&p0,const f32x16&p1){
  float a=max3f(p0[0],p0[1],p1[0]),b=max3f(p0[2],p0[3],p1[1]);a=max3f(a,p1[2],p1[3]);
  #pragma unroll
  for(int r=4;r<16;r+=4){a=max3f(a,p0[r],p0[r+1]);b=max3f(b,p0[r+2],p0[r+3]);a=max3f(a,p1[r],p1[r+1]);b=max3f(b,p1[r+2],p1[r+3]);}
  const float m=max2f(a,b);
  auto rr=__builtin_amdgcn_permlane32_swap(__float_as_uint(m),__float_as_uint(m),false,false);
  return max2f(__uint_as_float(rr[0]),__uint_as_float(rr[1]));
}
__device__ __forceinline__ void pv(f32x16*o,int vb,bf16x8 pa0,bf16x8 pa1,bf16x8 pa2,bf16x8 pa3){
  #pragma unroll
  for(int d0=0;d0<2;++d0){s16x4 lo[4],hi[4];
    #pragma unroll
    for(int ks=0;ks<4;++ks){
      asm volatile("ds_read_b64_tr_b16 %0,%1 offset:%c2":"=&v"(lo[ks]):"v"(vb),"i"(d0*4096+ks*1024):"memory");
      asm volatile("ds_read_b64_tr_b16 %0,%1 offset:%c2":"=&v"(hi[ks]):"v"(vb),"i"(d0*4096+ks*1024+512):"memory");}
    asm volatile("s_waitcnt lgkmcnt(0)":::"memory");SBAR();
    #define PK(k) (bf16x8){lo[k][0],lo[k][1],lo[k][2],lo[k][3],hi[k][0],hi[k][1],hi[k][2],hi[k][3]}
    o[d0]=__builtin_amdgcn_mfma_f32_32x32x16_bf16(pa0,PK(0),o[d0],0,0,0);
    o[d0]=__builtin_amdgcn_mfma_f32_32x32x16_bf16(pa1,PK(1),o[d0],0,0,0);
    o[d0]=__builtin_amdgcn_mfma_f32_32x32x16_bf16(pa2,PK(2),o[d0],0,0,0);
    o[d0]=__builtin_amdgcn_mfma_f32_32x32x16_bf16(pa3,PK(3),o[d0],0,0,0);
    #undef PK
  }
}

#ifndef ATTN_STORE16
#define ATTN_STORE16(p,v) (*(u32x4*)(p)=(v))
#endif
template<int THRL> __device__ __forceinline__ void attn_unit(int b,int qb,const bf16*Q,const bf16*__restrict__ K,const bf16*__restrict__ V,bf16*O,char*shm,const __attribute__((address_space(3))) float*rt){
  int tid_l=threadIdx.x; asm volatile("":"+v"(tid_l)); const int tid=tid_l,lane=tid&63,r32=lane&31,hi=lane>>5; const int wid=__builtin_amdgcn_readfirstlane(tid>>6);
  const long rowbase=(long)b*SEQ; const int q0=qb*QB;
  const bf16*Qw=Q+(rowbase+q0+wid*QBLK)*QP;
  const bf16*Kh=K+rowbase*KP,*Vh=V+rowbase*VP;
  const unsigned lds0=(unsigned)(uintptr_t)shm;
  float*wsf=(float*)(shm+LDS_WS)+wid*64;
  const bf16*ksrc=Kh+(long)lane*KP+wid*8;
  const bf16*vsrc=Vh+(long)(16*(wid&3)+(lane>>2))*VP+(wid>>2)*32+(lane&3)*8;
  const unsigned kdst=lds0+LDS_K+wid*1024, vdst=lds0+LDS_V+wid*1024;
  #define DMA_K(t,slot) glds16(ksrc+(long)(t)*KVBLK*KP,(unsigned)__builtin_amdgcn_readfirstlane(kdst+(slot)))
  #define DMA_V(t,slot) glds16(vsrc+(long)(t)*KVBLK*VP,(unsigned)__builtin_amdgcn_readfirstlane(vdst+(slot)))
  const int vb0=(int)(lds0+LDS_V)+((lane>>4)&1)*32+(lane&3)*8+(4*hi+((lane&15)>>2))*64;
  const char*Kbase=shm+LDS_K; bf16x8 kf[8];
  const lds_cptr shm3=(lds_cptr)shm; const lds_cptr kp0=shm3+LDS_K+hi*1024+r32*16; const lds_cptr vp0=shm3+LDS_V+((lane>>4)&1)*32+(lane&3)*8+(4*hi+((lane&15)>>2))*64;
  const int NT=(q0+QB)/KVBLK;
  DMA_K(0,0);DMA_V(0,0);DMA_K(1,SLOTB);
  bf16x8 qr[4];
  #pragma unroll
  for(int d0=0;d0<4;++d0)qr[d0]=*reinterpret_cast<const bf16x8*>(&Qw[(long)r32*QP+d0*16+hi*8]);
  float mhat=0.f,l_reg=0.f;f32x16 o[2];o[0]=f32x16{};o[1]=f32x16{};f32x16 negm=f32x16{};asm volatile("":"+v"(negm));
  const int qrel=wid*QBLK+r32;
  #define CMASK(P0,P1,t) do{int jb_=(t)-(NT-6); if(jb_>=0)bmask(P0,P1,jb_,qrel,hi,rt);}while(0)
  bool resc=false;
  #define START(P0,P1) do{ const float rm=rowmax(P0,P1); resc=false; \
    { const float dl=rm; mhat=fadd_s(mhat,dl); \
      _Pragma("unroll") for(int r=0;r<16;++r){P0[r]=fsub_s(P0[r],dl);P1[r]=fsub_s(P1[r],dl);} \
      _Pragma("unroll") for(int r=0;r<16;++r)negm[r]=-mhat; asm volatile("":"+v"(negm)); } \
    _Pragma("unroll") for(int r=0;r<16;++r)P0[r]=__builtin_amdgcn_exp2f(P0[r]); }while(0)
  #define RESC() do{ if(resc){ asm volatile("s_waitcnt lgkmcnt(0)":::"memory"); \
      _Pragma("unroll") for(int d_=0;d_<2;++d_) _Pragma("unroll") for(int r=0;r<16;++r)o[d_][r]*=wsf[crow(r,hi)]; } }while(0)
  f32x16 pA0,pA1,pB0,pB1;
  int sl_prev=0,sl_cur=0,sl_next=SLOTB;
  #define ROT() do{sl_prev=sl_cur;sl_cur=sl_next;sl_next=(sl_next==(NSLOT-1)*SLOTB)?0:sl_next+SLOTB;}while(0)
  DMA_K(2,2*SLOTB);
  WAIT_BAR(3);
  qkt(pA0,pA1,Kbase,qr,negm,r32,hi);asm volatile("s_nop 15\n\ts_nop 7":"+v"(pA0),"+v"(pA1));CMASK(pA0,pA1,0);
  START(pA0,pA1);
  _Pragma("unroll") for(int r=0;r<16;++r)pA1[r]=__builtin_amdgcn_exp2f(pA1[r]);
  WAIT_BAR(0);
  DMA_K(3,0);DMA_V(1,SLOTB);
  ROT();
  kload8(kf,kp0+sl_cur);
  WAIT_BAR(2);
  s16x4 vlo[8],vhi[8]; u32x4 pw0,pw1,pw2,pw3;
  #define PKW(P,B) cvtpk_s(P[B],P[B+1])
  #define PAF(k) __builtin_bit_cast(bf16x8,pw##k)
  #define VFR(i) (bf16x8){vlo[i][0],vlo[i][1],vlo[i][2],vlo[i][3],vhi[i][0],vhi[i][1],vhi[i][2],vhi[i][3]}
  #define PIN(x) asm volatile("":"+v"(x))
  #define MX3(a,b,c) __builtin_fmaxf(__builtin_fmaxf((a),(b)),(c))
  #define GAPA(MF,A0,A1,A2,A3,W0,W1,PW) do{ MF; sacc+=A0; sacc+=A1; sacc+=A2; sacc+=A3; PIN(sacc); W0; W1; PIN(PW); SBAR(); }while(0)
  #define EX(v) __builtin_amdgcn_exp2f(v)
  #define GAPB(MF,X,B) do{ MF; X[B]=EX(X[B]); X[B+1]=EX(X[B+1]); X[B+2]=EX(X[B+2]); X[B+3]=EX(X[B+3]); PIN(X); SBAR(); }while(0)
  #define VRD(i) do{ vlo[i]=vtr(vp_+(((i)>>2)*4096+((i)&3)*1024)); vhi[i]=vtr(vp_+(((i)>>2)*4096+((i)&3)*1024+512)); }while(0)
  #define KRD(G,j) do{ if(G){ kload2(kf,kp0+sl_next,j); SBAR(); } }while(0)
  #define STEP(C0,C1,P0,P1,t,GK,GV,GL) do{ SBAR(); \
    const lds_cptr vp_=vp0+sl_prev; \
    VRD(0); SBAR(); float sacc=(P0[0]+P0[1]); \
    GAPA(C0=__builtin_amdgcn_mfma_f32_32x32x16_bf16(kf[0],qr[0],negm,0,0,0), P0[2],P0[3],P0[4],P0[5],     pw0[0]=PKW(P0,0), pw0[1]=PKW(P0,2), pw0); \
    VRD(4); SBAR(); GAPA(C1=__builtin_amdgcn_mfma_f32_32x32x16_bf16(kf[1],qr[0],negm,0,0,0), P0[6],P0[7],P0[8],P0[9],     pw0[2]=PKW(P0,4), pw0[3]=PKW(P0,6), pw0); \
    VRD(1); SBAR(); GAPA(C0=__builtin_amdgcn_mfma_f32_32x32x16_bf16(kf[2],qr[1],C0,0,0,0),   P0[10],P0[11],P0[12],P0[13], pw1[0]=PKW(P0,8), pw1[1]=PKW(P0,10), pw1); \
    VRD(5); SBAR(); GAPA(C1=__builtin_amdgcn_mfma_f32_32x32x16_bf16(kf[3],qr[1],C1,0,0,0),   P0[14],P0[15],P1[0],P1[1],   pw1[2]=PKW(P0,12),pw1[3]=PKW(P0,14), pw1); \
    VRD(2); SBAR(); GAPA(C0=__builtin_amdgcn_mfma_f32_32x32x16_bf16(kf[4],qr[2],C0,0,0,0),   P1[2],P1[3],P1[4],P1[5],     pw2[0]=PKW(P1,0), pw2[1]=PKW(P1,2), pw2); \
    VRD(6); SBAR(); GAPA(C1=__builtin_amdgcn_mfma_f32_32x32x16_bf16(kf[5],qr[2],C1,0,0,0),   P1[6],P1[7],P1[8],P1[9],     pw2[2]=PKW(P1,4), pw2[3]=PKW(P1,6), pw2); \
    VRD(3); SBAR(); GAPA(C0=__builtin_amdgcn_mfma_f32_32x32x16_bf16(kf[6],qr[3],C0,0,0,0),   P1[10],P1[11],P1[12],P1[13], pw3[0]=PKW(P1,8), pw3[1]=PKW(P1,10), pw3); \
    VRD(7); SBAR(); GAPA(C1=__builtin_amdgcn_mfma_f32_32x32x16_bf16(kf[7],qr[3],C1,0,0,0),   P1[14],P1[15],0.f,0.f,       pw3[2]=PKW(P1,12),pw3[3]=PKW(P1,14), pw3); \
    l_reg+=sacc; \
    if(GK){DMA_K((t)+3,sl_cur);} if(GV){DMA_V((t)+1,sl_next);} \
    CMASK(C0,C1,t); \
    { float a=MX3(C0[0],C0[1],C1[0]),b=MX3(C0[2],C0[3],C1[1]); a=MX3(a,C1[2],C1[3]); \
      _Pragma("unroll") for(int r=4;r<16;r+=4){a=MX3(a,C0[r],C0[r+1]);b=MX3(b,C0[r+2],C0[r+3]);a=MX3(a,C1[r],C1[r+1]);b=MX3(b,C1[r+2],C1[r+3]);} \
      float rm=__builtin_fmaxf(a,b); { auto rr=__builtin_amdgcn_permlane32_swap(__float_as_uint(rm),__float_as_uint(rm),false,false); rm=__builtin_fmaxf(__uint_as_float(rr[0]),__uint_as_float(rr[1])); } \
      resc=false; \
      if(__builtin_expect(__any(rm>(float)THRL),0)){ const float dl=__builtin_fmaxf(rm,0.f); mhat+=dl; \
        _Pragma("unroll") for(int r=0;r<16;++r){C0[r]-=dl;C1[r]-=dl;} \
        _Pragma("unroll") for(int r=0;r<16;++r)negm[r]=-mhat; asm volatile("":"+v"(negm)); \
        const float f=__builtin_amdgcn_exp2f(-dl); l_reg*=f; if(hi==0)wsf[r32]=f; resc=true; } } \
    SBAR(); \
    GAPB(o[0]=__builtin_amdgcn_mfma_f32_32x32x16_bf16(PAF(0),VFR(0),o[0],0,0,0), C0,0); \
    GAPB(o[1]=__builtin_amdgcn_mfma_f32_32x32x16_bf16(PAF(0),VFR(4),o[1],0,0,0), C0,4); \
    KRD(GL,0); GAPB(o[0]=__builtin_amdgcn_mfma_f32_32x32x16_bf16(PAF(1),VFR(1),o[0],0,0,0), C0,8); \
    KRD(GL,1); GAPB(o[1]=__builtin_amdgcn_mfma_f32_32x32x16_bf16(PAF(1),VFR(5),o[1],0,0,0), C0,12); \
    KRD(GL,2); GAPB(o[0]=__builtin_amdgcn_mfma_f32_32x32x16_bf16(PAF(2),VFR(2),o[0],0,0,0), C1,0); \
    KRD(GL,3); GAPB(o[1]=__builtin_amdgcn_mfma_f32_32x32x16_bf16(PAF(2),VFR(6),o[1],0,0,0), C1,4); \
    GAPB(o[0]=__builtin_amdgcn_mfma_f32_32x32x16_bf16(PAF(3),VFR(3),o[0],0,0,0), C1,8); \
    GAPB(o[1]=__builtin_amdgcn_mfma_f32_32x32x16_bf16(PAF(3),VFR(7),o[1],0,0,0), C1,12); \
    }while(0)
  int t=1;
  #undef CMASK
  #define CMASK(P0,P1,t) do{}while(0)
  for(;t+7<NT;t+=2){
    STEP(pB0,pB1,pA0,pA1,t,true,true,true);     WAIT_BAR(2); RESC(); ROT();
    STEP(pA0,pA1,pB0,pB1,t+1,true,true,true);   WAIT_BAR(2); RESC(); ROT();
  }
  #undef CMASK
  #define CMASK(P0,P1,t) do{int jb_=(t)-(NT-6); if(jb_>=0)bmask(P0,P1,jb_,qrel,hi,rt);}while(0)
  #define ENDW(tt) do{ if((tt)+3<NT){WAIT_BAR(2);} else if((tt)+2<NT){WAIT_BAR(1);} else {WAIT_BAR(0);} }while(0)
  for(;t+1<NT;t+=2){
    STEP(pB0,pB1,pA0,pA1,t,(t+3<NT),(t+1<NT),(t+1<NT));       ENDW(t);   RESC(); ROT();
    STEP(pA0,pA1,pB0,pB1,t+1,(t+4<NT),(t+2<NT),(t+2<NT));     ENDW(t+1); RESC(); ROT();
  }
  STEP(pB0,pB1,pA0,pA1,NT-1,false,false,false); RESC();
  { float sacc=pB0[0]+pB0[1]; _Pragma("unroll") for(int r=2;r<16;++r)sacc+=pB0[r]; _Pragma("unroll") for(int r=0;r<16;++r)sacc+=pB1[r]; l_reg+=sacc;
    pw0=(u32x4){PKW(pB0,0),PKW(pB0,2),PKW(pB0,4),PKW(pB0,6)};pw1=(u32x4){PKW(pB0,8),PKW(pB0,10),PKW(pB0,12),PKW(pB0,14)};pw2=(u32x4){PKW(pB1,0),PKW(pB1,2),PKW(pB1,4),PKW(pB1,6)};pw3=(u32x4){PKW(pB1,8),PKW(pB1,10),PKW(pB1,12),PKW(pB1,14)};
    SBAR(); pv(o,vb0+sl_cur,PAF(0),PAF(1),PAF(2),PAF(3)); }
  #undef PKW
  #undef PAF
  #undef VFR
  #undef PIN
  #undef MX3
  #undef GAPA
  #undef GAPB
  #undef EX
  #undef VRD
  #undef KRD
  #undef STEP
  #undef ENDW
  {auto rr=__builtin_amdgcn_permlane32_swap(__float_as_uint(l_reg),__float_as_uint(l_reg),false,false);l_reg=__uint_as_float(rr[0])+__uint_as_float(rr[1]);}
  if(hi==0)wsf[32+r32]=l_reg;asm volatile("s_waitcnt lgkmcnt(0)":::"memory");
  float rli[16];
  #pragma unroll
  for(int r=0;r<16;++r)rli[r]=__builtin_amdgcn_rcpf(wsf[32+crow(r,hi)]);
  bf16*Ow=O+(rowbase+q0+wid*QBLK)*OP;
  { bf16*stg=(bf16*)(shm+LDS_OST)+wid*2048;
    #pragma unroll
    for(int r=0;r<16;++r){const int orow=crow(r,hi);
      #pragma unroll
      for(int d0=0;d0<2;++d0)stg[orow*64+d0*32+r32]=__float2bfloat16(o[d0][r]*rli[r]);}
    asm volatile("s_waitcnt lgkmcnt(0)":::"memory");
    #pragma unroll
    for(int i=0;i<4;++i){const int row=i*8+(lane>>3),ch=lane&7; const u32x4 v=*(const u32x4*)(stg+row*64+ch*8); ATTN_STORE16(Ow+(long)row*OP+ch*8,v);} }
  asm volatile("s_waitcnt lgkmcnt(0)\n\ts_barrier":::"memory");
  #undef DMA_K
  #undef DMA_V
  #undef CMASK
  #undef START
  #undef RESC
  #undef ROT
}
constexpr int VSLOTB=16384;
constexpr int L2_K=0, L2_V=NSLOT*SLOTB, L2_WS=L2_V+NSLOT*VSLOTB, L2_BYTES=L2_WS+NW*64*4;
template<int DUMMY> __device__ __forceinline__ void attn_unit2(int b,int qb,const bf16*Q,const bf16*__restrict__ K,const bf16*__restrict__ V,bf16*O,char*shm,const __attribute__((address_space(3))) float*rt){
  int tid_l=threadIdx.x; asm volatile("":"+v"(tid_l)); const int tid=tid_l,lane=tid&63,r32=lane&31,hi=lane>>5; const int wid=__builtin_amdgcn_readfirstlane(tid>>6);
  const long rowbase=(long)b*SEQ; const int q0=qb*QB;
  const bf16*Qw=Q+(rowbase+q0+wid*QBLK)*QP;
  const bf16*Kh=K+rowbase*KP,*Vh=V+rowbase*VP;
  const unsigned lds0=(unsigned)(uintptr_t)shm;
  float*wsf=(float*)(shm+L2_WS)+wid*64;
  const bf16*ksrc=Kh+(long)lane*KP+wid*8;
  const bf16*vsrc=Vh+(long)(16*(wid&3)+(lane>>2))*VP+(wid>>2)*32+(lane&3)*8;
  const unsigned kdst=lds0+L2_K+wid*1024, vdst=lds0+L2_V+wid*1024;
  #define DMA_K(t,slot) glds16(ksrc+(long)(t)*KVBLK*KP,(unsigned)__builtin_amdgcn_readfirstlane(kdst+(slot)))
  #define DMA_V(t,slot) do{ glds16(vsrc+(long)(t)*KVBLK*VP,(unsigned)__builtin_amdgcn_readfirstlane(vdst+(slot))); glds16(vsrc+(long)(t)*KVBLK*VP+64,(unsigned)__builtin_amdgcn_readfirstlane(vdst+(slot)+8192)); }while(0)
  const char*Kbase=shm+L2_K; bf16x8 kf[8];
  const lds_cptr shm3=(lds_cptr)shm; const lds_cptr kp0=shm3+L2_K+hi*1024+r32*16; const lds_cptr vp0=shm3+L2_V+((lane>>4)&1)*32+(lane&3)*8+(4*hi+((lane&15)>>2))*64;
  const int NT=(q0+QB)/KVBLK;
  DMA_K(0,0);DMA_V(0,0);DMA_K(1,SLOTB);
  bf16x8 qr[4];
  #pragma unroll
  for(int d0=0;d0<4;++d0)qr[d0]=*reinterpret_cast<const bf16x8*>(&Qw[(long)r32*QP+d0*16+hi*8]);
  DMA_K(2,2*SLOTB);
  float l_reg=0.f; f32x16 o[4]; o[0]=f32x16{};o[1]=f32x16{};o[2]=f32x16{};o[3]=f32x16{};
  const f32x16 zero16=f32x16{};
  const int qrel=wid*QBLK+r32;
  #define BMASK(P0,P1,t) do{int jb_=(t)-(NT-6); if(jb_>=0)bmask(P0,P1,jb_,qrel,hi,rt);}while(0)
  #define PKW(P,B) cvtpk_s(P[B],P[B+1])
  f32x16 c0,c1; u32x4 pw0,pw1,pw2,pw3;
  WAIT_BAR(1);
  qkt(c0,c1,Kbase,qr,zero16,r32,hi); BMASK(c0,c1,0);
  { float sacc=0.f;
    #pragma unroll
    for(int r=0;r<16;++r){c0[r]=__builtin_amdgcn_exp2f(c0[r]);c1[r]=__builtin_amdgcn_exp2f(c1[r]);}
    #pragma unroll
    for(int r=0;r<16;++r)sacc+=c0[r]+c1[r];
    l_reg+=sacc;
    pw0=(u32x4){PKW(c0,0),PKW(c0,2),PKW(c0,4),PKW(c0,6)};pw1=(u32x4){PKW(c0,8),PKW(c0,10),PKW(c0,12),PKW(c0,14)};pw2=(u32x4){PKW(c1,0),PKW(c1,2),PKW(c1,4),PKW(c1,6)};pw3=(u32x4){PKW(c1,8),PKW(c1,10),PKW(c1,12),PKW(c1,14)}; }
  WAIT_BAR(0);
  DMA_K(3,0);DMA_V(1,VSLOTB);
  kload8(kf,kp0+SLOTB);
  WAIT_BAR(3);
  int ks_cur=SLOTB, ks_next=2*SLOTB;
  int vs_prev=0, vs_next=2*VSLOTB;
  s16x4 vlo[16],vhi[16];
  #define PAF(k) __builtin_bit_cast(bf16x8,pw##k)
  #define VFR(i) (bf16x8){vlo[i][0],vlo[i][1],vlo[i][2],vlo[i][3],vhi[i][0],vhi[i][1],vhi[i][2],vhi[i][3]}
  #define PIN(x) asm volatile("":"+v"(x))
  #define EX(v) __builtin_amdgcn_exp2f(v)
  #define VRD(i) do{ vlo[i]=vtr(vp_+(((i)>>2)*4096+((i)&3)*1024)); vhi[i]=vtr(vp_+(((i)>>2)*4096+((i)&3)*1024+512)); }while(0)
  #define GA(VI,MF) do{ VRD(VI); SBAR(); MF; SBAR(); }while(0)
  #define GB0(MF,X,E) do{ MF; X[E]=EX(X[E]); X[E+1]=EX(X[E+1]); PIN(X); SBAR(); }while(0)
  #define GB1(MF,X,E,G,GE,PW,IDX) do{ MF; X[E]=EX(X[E]); X[E+1]=EX(X[E+1]); PIN(X); sacc+=G[GE]; sacc+=G[GE+1]; PIN(sacc); PW[IDX]=PKW(G,GE); PIN(PW); SBAR(); }while(0)
  #define KRD(G,j) do{ if(G){ kload2(kf,kp0+ks_next,j); SBAR(); } }while(0)
  #define MF_O(D0,KS) o[D0]=__builtin_amdgcn_mfma_f32_32x32x16_bf16(PAF(KS),VFR((D0)*4+(KS)),o[D0],0,0,0)
  #define STEP2(t,GK,GV,GL) do{ SBAR(); \
    const lds_cptr vp_=vp0+vs_prev; \
    GA(0, c0=__builtin_amdgcn_mfma_f32_32x32x16_bf16(kf[0],qr[0],zero16,0,0,0)); \
    GA(4, c1=__builtin_amdgcn_mfma_f32_32x32x16_bf16(kf[1],qr[0],zero16,0,0,0)); \
    GA(8, c0=__builtin_amdgcn_mfma_f32_32x32x16_bf16(kf[2],qr[1],c0,0,0,0)); \
    GA(12,c1=__builtin_amdgcn_mfma_f32_32x32x16_bf16(kf[3],qr[1],c1,0,0,0)); \
    GA(1, c0=__builtin_amdgcn_mfma_f32_32x32x16_bf16(kf[4],qr[2],c0,0,0,0)); \
    GA(5, c1=__builtin_amdgcn_mfma_f32_32x32x16_bf16(kf[5],qr[2],c1,0,0,0)); \
    GA(9, c0=__builtin_amdgcn_mfma_f32_32x32x16_bf16(kf[6],qr[3],c0,0,0,0)); \
    GA(13,c1=__builtin_amdgcn_mfma_f32_32x32x16_bf16(kf[7],qr[3],c1,0,0,0)); \
    if(GK){DMA_K((t)+3,ks_cur);} if(GV){DMA_V((t)+1,vs_next);} \
    BMASK(c0,c1,t); \
    SBAR(); float sacc=0.f; \
    GB0(MF_O(0,0),c0,0);  VRD(2);  SBAR(); \
    GB0(MF_O(1,0),c0,2);  VRD(6);  SBAR(); \
    KRD(GL,0); GB0(MF_O(2,0),c0,4);  VRD(10); SBAR(); \
    KRD(GL,1); GB0(MF_O(3,0),c0,6);  VRD(14); SBAR(); \
    KRD(GL,2); GB1(MF_O(0,1),c0,8, c0,0,pw0,0); VRD(3);  SBAR(); \
    KRD(GL,3); GB1(MF_O(1,1),c0,10,c0,2,pw0,1); VRD(7);  SBAR(); \
    GB1(MF_O(2,1),c0,12,c0,4,pw0,2); VRD(11); SBAR(); \
    GB1(MF_O(3,1),c0,14,c0,6,pw0,3); VRD(15); SBAR(); \
    GB1(MF_O(0,2),c1,0, c0,8, pw1,0); \
    GB1(MF_O(1,2),c1,2, c0,10,pw1,1); \
    GB1(MF_O(2,2),c1,4, c0,12,pw1,2); \
    GB1(MF_O(3,2),c1,6, c0,14,pw1,3); \
    GB1(MF_O(0,3),c1,8, c1,0,pw2,0); \
    GB1(MF_O(1,3),c1,10,c1,2,pw2,1); \
    GB1(MF_O(2,3),c1,12,c1,4,pw2,2); \
    GB1(MF_O(3,3),c1,14,c1,6,pw2,3); \
    sacc+=c1[8]; sacc+=c1[9]; sacc+=c1[10]; sacc+=c1[11]; sacc+=c1[12]; sacc+=c1[13]; sacc+=c1[14]; sacc+=c1[15]; \
    pw3=(u32x4){PKW(c1,8),PKW(c1,10),PKW(c1,12),PKW(c1,14)}; PIN(pw3); l_reg+=sacc; SBAR(); \
    }while(0)
  #define ROT2() do{ ks_cur=ks_next; ks_next=(ks_next==(NSLOT-1)*SLOTB)?0:ks_next+SLOTB; vs_prev=(vs_prev==(NSLOT-1)*VSLOTB)?0:vs_prev+VSLOTB; vs_next=(vs_next==(NSLOT-1)*VSLOTB)?0:vs_next+VSLOTB; }while(0)
  int t=1;
  for(;t+3<NT;++t){ STEP2(t,true,true,true); WAIT_BAR(3); ROT2(); }
  for(;t<NT;++t){
    STEP2(t,(t+3<NT),(t+1<NT),(t+1<NT));
    if(t+1<NT){ WAIT_BAR(2); } else { WAIT_BAR(0); }
    ROT2();
  }
  { const lds_cptr vp_=vp0+vs_prev;
    #pragma unroll
    for(int d0=0;d0<4;++d0){
      #pragma unroll
      for(int ks=0;ks<4;++ks){ VRD(d0*4+ks); }
      o[d0]=__builtin_amdgcn_mfma_f32_32x32x16_bf16(PAF(0),VFR(d0*4+0),o[d0],0,0,0);
      o[d0]=__builtin_amdgcn_mfma_f32_32x32x16_bf16(PAF(1),VFR(d0*4+1),o[d0],0,0,0);
      o[d0]=__builtin_amdgcn_mfma_f32_32x32x16_bf16(PAF(2),VFR(d0*4+2),o[d0],0,0,0);
      o[d0]=__builtin_amdgcn_mfma_f32_32x32x16_bf16(PAF(3),VFR(d0*4+3),o[d0],0,0,0); } }
  {auto rr=__builtin_amdgcn_permlane32_swap(__float_as_uint(l_reg),__float_as_uint(l_reg),false,false);l_reg=__uint_as_float(rr[0])+__uint_as_float(rr[1]);}
  if(hi==0)wsf[32+r32]=l_reg;
  asm volatile("s_waitcnt lgkmcnt(0)\n\ts_barrier":::"memory");
  float rli[16];
  #pragma unroll
  for(int r=0;r<16;++r)rli[r]=__builtin_amdgcn_rcpf(wsf[32+crow(r,hi)]);
  bf16*Ow=O+(rowbase+q0+wid*QBLK)*OP;
  { bf16*stg=(bf16*)(shm)+wid*4096;
    #pragma unroll
    for(int r=0;r<16;++r){const int orow=crow(r,hi);
      #pragma unroll
      for(int d0=0;d0<4;++d0)stg[orow*128+d0*32+r32]=__float2bfloat16(o[d0][r]*rli[r]);}
    asm volatile("s_waitcnt lgkmcnt(0)":::"memory");
    #pragma unroll
    for(int i=0;i<8;++i){const int row=i*4+(lane>>4),ch=lane&15; const u32x4 v=*(const u32x4*)(stg+row*128+ch*8); ATTN_STORE16(Ow+(long)row*OP+ch*8,v);} }
  asm volatile("s_waitcnt lgkmcnt(0)\n\ts_barrier":::"memory");
  #undef DMA_K
  #undef DMA_V
  #undef BMASK
  #undef PKW
  #undef PAF
  #undef VFR
  #undef PIN
  #undef EX
  #undef VRD
  #undef GA
  #undef GB0
  #undef GB1
  #undef KRD
  #undef MF_O
  #undef STEP2
  #undef ROT2
}
constexpr int ATTN2_LDS_BYTES=L2_BYTES;

constexpr int NS3=4;
constexpr int L3_K=0, L3_V=NS3*SLOTB, L3_WS=L3_V+NS3*VSLOTB, L3_BYTES=L3_WS+NW*64*4;
template<int DUMMY> __device__ __forceinline__ void attn_unit3(int b,int qb,const bf16*Q,const bf16*__restrict__ K,const bf16*__restrict__ V,bf16*O,char*shm,const __attribute__((address_space(3))) float*rt){
  int tid_l=threadIdx.x; asm volatile("":"+v"(tid_l)); const int tid=tid_l,lane=tid&63,r32=lane&31,hi=lane>>5; const int wid=__builtin_amdgcn_readfirstlane(tid>>6);
  const long rowbase=(long)b*SEQ; const int q0=qb*QB;
  const bf16*Qw=Q+(rowbase+q0+wid*QBLK)*QP;
  const bf16*Kh=K+rowbase*KP,*Vh=V+rowbase*VP;
  const unsigned lds0=(unsigned)(uintptr_t)shm;
  float*wsf=(float*)(shm+L3_WS)+wid*64;
  const bf16*ksrc=Kh+(long)lane*KP+wid*8;
  const bf16*vsrc=Vh+(long)(16*(wid&3)+(lane>>2))*VP+(wid>>2)*32+(lane&3)*8;
  const unsigned kdst=lds0+L3_K+wid*1024, vdst=lds0+L3_V+wid*1024;
  #define DMA_K(t,slot) glds16(ksrc+(long)(t)*KVBLK*KP,(unsigned)__builtin_amdgcn_readfirstlane(kdst+(slot)))
  #define DMA_V(t,slot) do{ glds16(vsrc+(long)(t)*KVBLK*VP,(unsigned)__builtin_amdgcn_readfirstlane(vdst+(slot))); glds16(vsrc+(long)(t)*KVBLK*VP+64,(unsigned)__builtin_amdgcn_readfirstlane(vdst+(slot)+8192)); }while(0)
  const char*Kbase=shm+L3_K; bf16x8 kf[8];
  const lds_cptr shm3=(lds_cptr)shm; const lds_cptr kp0=shm3+L3_K+hi*1024+r32*16; const lds_cptr vp0=shm3+L3_V+((lane>>4)&1)*32+(lane&3)*8+(4*hi+((lane&15)>>2))*64;
  const int NT=(q0+QB)/KVBLK;
  DMA_K(0,0);DMA_V(0,0);DMA_K(1,SLOTB);
  bf16x8 qr[4];
  #pragma unroll
  for(int d0=0;d0<4;++d0)qr[d0]=*reinterpret_cast<const bf16x8*>(&Qw[(long)r32*QP+d0*16+hi*8]);
  DMA_K(2,2*SLOTB);DMA_V(1,VSLOTB);
  float l_reg=0.f; f32x16 o[4]; o[0]=f32x16{};o[1]=f32x16{};o[2]=f32x16{};o[3]=f32x16{};
  const f32x16 zero16=f32x16{};
  const int qrel=wid*QBLK+r32;
  #define BMASK(P0,P1,t) do{int jb_=(t)-(NT-6); if(jb_>=0)bmask(P0,P1,jb_,qrel,hi,rt);}while(0)
  #define PKW(P,B) cvtpk_s(P[B],P[B+1])
  f32x16 c0,c1; u32x4 pw0,pw1,pw2,pw3;
  WAIT_BAR(3);
  qkt(c0,c1,Kbase,qr,zero16,r32,hi); BMASK(c0,c1,0);
  { float sacc=0.f;
    #pragma unroll
    for(int r=0;r<16;++r){c0[r]=__builtin_amdgcn_exp2f(c0[r]);c1[r]=__builtin_amdgcn_exp2f(c1[r]);}
    #pragma unroll
    for(int r=0;r<16;++r)sacc+=c0[r]+c1[r];
    l_reg+=sacc;
    pw0=(u32x4){PKW(c0,0),PKW(c0,2),PKW(c0,4),PKW(c0,6)};pw1=(u32x4){PKW(c0,8),PKW(c0,10),PKW(c0,12),PKW(c0,14)};pw2=(u32x4){PKW(c1,0),PKW(c1,2),PKW(c1,4),PKW(c1,6)};pw3=(u32x4){PKW(c1,8),PKW(c1,10),PKW(c1,12),PKW(c1,14)}; }
  WAIT_BAR(0);
  DMA_K(3,3*SLOTB);DMA_V(2,2*VSLOTB);
  kload8(kf,kp0+SLOTB);
  WAIT_BAR(3);
  if(wid>=4){ asm volatile("s_barrier":::"memory"); }
  int ks_next=2*SLOTB, ks_iss=0;
  int vs_prev=0, vs_next=3*VSLOTB;
  s16x4 vlo[16],vhi[16];
  #define PAF(k) __builtin_bit_cast(bf16x8,pw##k)
  #define VFR(i) (bf16x8){vlo[i][0],vlo[i][1],vlo[i][2],vlo[i][3],vhi[i][0],vhi[i][1],vhi[i][2],vhi[i][3]}
  #define PIN(x) asm volatile("":"+v"(x))
  #define EX(v) __builtin_amdgcn_exp2f(v)
  #define VRD(i) do{ vlo[i]=vtr(vp_+(((i)>>2)*4096+((i)&3)*1024)); vhi[i]=vtr(vp_+(((i)>>2)*4096+((i)&3)*1024+512)); }while(0)
  #define GA(VI,MF) do{ VRD(VI); SBAR(); MF; SBAR(); }while(0)
  #define GB0(MF,X,E) do{ MF; X[E]=EX(X[E]); X[E+1]=EX(X[E+1]); PIN(X); SBAR(); }while(0)
  #define GB1(MF,X,E,G,GE,PW,IDX) do{ MF; X[E]=EX(X[E]); X[E+1]=EX(X[E+1]); PIN(X); sacc+=G[GE]; sacc+=G[GE+1]; PIN(sacc); PW[IDX]=PKW(G,GE); PIN(PW); SBAR(); }while(0)
  #define KRD(G,j) do{ if(G){ kload2(kf,kp0+ks_next,j); SBAR(); } }while(0)
  #define MF_O(D0,KS) o[D0]=__builtin_amdgcn_mfma_f32_32x32x16_bf16(PAF(KS),VFR((D0)*4+(KS)),o[D0],0,0,0)
  #define STEP2(t,GK,GV,GL) do{ SBAR(); \
    const lds_cptr vp_=vp0+vs_prev; \
    GA(0, c0=__builtin_amdgcn_mfma_f32_32x32x16_bf16(kf[0],qr[0],zero16,0,0,0)); \
    GA(4, c1=__builtin_amdgcn_mfma_f32_32x32x16_bf16(kf[1],qr[0],zero16,0,0,0)); \
    GA(8, c0=__builtin_amdgcn_mfma_f32_32x32x16_bf16(kf[2],qr[1],c0,0,0,0)); \
    GA(12,c1=__builtin_amdgcn_mfma_f32_32x32x16_bf16(kf[3],qr[1],c1,0,0,0)); \
    GA(1, c0=__builtin_amdgcn_mfma_f32_32x32x16_bf16(kf[4],qr[2],c0,0,0,0)); \
    GA(5, c1=__builtin_amdgcn_mfma_f32_32x32x16_bf16(kf[5],qr[2],c1,0,0,0)); \
    GA(9, c0=__builtin_amdgcn_mfma_f32_32x32x16_bf16(kf[6],qr[3],c0,0,0,0)); \
    GA(13,c1=__builtin_amdgcn_mfma_f32_32x32x16_bf16(kf[7],qr[3],c1,0,0,0)); \
    BMASK(c0,c1,t); \
    asm volatile("s_barrier":::"memory"); \
    if(GK){DMA_K((t)+3,ks_iss);} if(GV){DMA_V((t)+2,vs_next);} \
    SBAR(); float sacc=0.f; \
    GB0(MF_O(0,0),c0,0);  VRD(2);  SBAR(); \
    GB0(MF_O(1,0),c0,2);  VRD(6);  SBAR(); \
    KRD(GL,0); GB0(MF_O(2,0),c0,4);  VRD(10); SBAR(); \
    KRD(GL,1); GB0(MF_O(3,0),c0,6);  VRD(14); SBAR(); \
    KRD(GL,2); GB1(MF_O(0,1),c0,8, c0,0,pw0,0); VRD(3);  SBAR(); \
    KRD(GL,3); GB1(MF_O(1,1),c0,10,c0,2,pw0,1); VRD(7);  SBAR(); \
    GB1(MF_O(2,1),c0,12,c0,4,pw0,2); VRD(11); SBAR(); \
    GB1(MF_O(3,1),c0,14,c0,6,pw0,3); VRD(15); SBAR(); \
    GB1(MF_O(0,2),c1,0, c0,8, pw1,0); \
    GB1(MF_O(1,2),c1,2, c0,10,pw1,1); \
    GB1(MF_O(2,2),c1,4, c0,12,pw1,2); \
    GB1(MF_O(3,2),c1,6, c0,14,pw1,3); \
    GB1(MF_O(0,3),c1,8, c1,0,pw2,0); \
    GB1(MF_O(1,3),c1,10,c1,2,pw2,1); \
    GB1(MF_O(2,3),c1,12,c1,4,pw2,2); \
    GB1(MF_O(3,3),c1,14,c1,6,pw2,3); \
    sacc+=c1[8]; sacc+=c1[9]; sacc+=c1[10]; sacc+=c1[11]; sacc+=c1[12]; sacc+=c1[13]; sacc+=c1[14]; sacc+=c1[15]; \
    pw3=(u32x4){PKW(c1,8),PKW(c1,10),PKW(c1,12),PKW(c1,14)}; PIN(pw3); l_reg+=sacc; SBAR(); \
    }while(0)
  #define ROT2() do{ ks_next=(ks_next==(NS3-1)*SLOTB)?0:ks_next+SLOTB; ks_iss=(ks_iss==(NS3-1)*SLOTB)?0:ks_iss+SLOTB; vs_prev=(vs_prev==(NS3-1)*VSLOTB)?0:vs_prev+VSLOTB; vs_next=(vs_next==(NS3-1)*VSLOTB)?0:vs_next+VSLOTB; }while(0)
  int t=1;
  for(;t+3<NT;++t){ STEP2(t,true,true,true); WAIT_BAR(3); ROT2(); }
  for(;t<NT;++t){
    STEP2(t,false,(t+2<NT),(t+1<NT));
    if(t+2<NT){ WAIT_BAR(2); } else { WAIT_BAR(0); }
    ROT2();
  }
  if(wid<4){ asm volatile("s_barrier":::"memory"); }
  { const lds_cptr vp_=vp0+vs_prev;
    #pragma unroll
    for(int d0=0;d0<4;++d0){
      #pragma unroll
      for(int ks=0;ks<4;++ks){ VRD(d0*4+ks); }
      o[d0]=__builtin_amdgcn_mfma_f32_32x32x16_bf16(PAF(0),VFR(d0*4+0),o[d0],0,0,0);
      o[d0]=__builtin_amdgcn_mfma_f32_32x32x16_bf16(PAF(1),VFR(d0*4+1),o[d0],0,0,0);
      o[d0]=__builtin_amdgcn_mfma_f32_32x32x16_bf16(PAF(2),VFR(d0*4+2),o[d0],0,0,0);
      o[d0]=__builtin_amdgcn_mfma_f32_32x32x16_bf16(PAF(3),VFR(d0*4+3),o[d0],0,0,0); } }
  {auto rr=__builtin_amdgcn_permlane32_swap(__float_as_uint(l_reg),__float_as_uint(l_reg),false,false);l_reg=__uint_as_float(rr[0])+__uint_as_float(rr[1]);}
  if(hi==0)wsf[32+r32]=l_reg;
  asm volatile("s_waitcnt lgkmcnt(0)\n\ts_barrier":::"memory");
  float rli[16];
  #pragma unroll
  for(int r=0;r<16;++r)rli[r]=__builtin_amdgcn_rcpf(wsf[32+crow(r,hi)]);
  bf16*Ow=O+(rowbase+q0+wid*QBLK)*OP;
  { bf16*stg=(bf16*)(shm)+wid*4096;
    #pragma unroll
    for(int r=0;r<16;++r){const int orow=crow(r,hi);
      #pragma unroll
      for(int d0=0;d0<4;++d0)stg[orow*128+d0*32+r32]=__float2bfloat16(o[d0][r]*rli[r]);}
    asm volatile("s_waitcnt lgkmcnt(0)":::"memory");
    #pragma unroll
    for(int i=0;i<8;++i){const int row=i*4+(lane>>4),ch=lane&15; const u32x4 v=*(const u32x4*)(stg+row*128+ch*8); ATTN_STORE16(Ow+(long)row*OP+ch*8,v);} }
  asm volatile("s_waitcnt lgkmcnt(0)\n\ts_barrier":::"memory");
  #undef DMA_K
  #undef DMA_V
  #undef BMASK
  #undef PKW
  #undef PAF
  #undef VFR
  #undef PIN
  #undef EX
  #undef VRD
  #undef GA
  #undef GB0
  #undef GB1
  #undef KRD
  #undef MF_O
  #undef STEP2
  #undef ROT2
}
constexpr int ATTN3_LDS_BYTES=L3_BYTES;
constexpr int ATTN_LDS_BYTES=LDS_BYTES;
#undef SBAR
#undef WAIT_BAR
}
#define GAS __attribute__((address_space(1)))
#define LAS __attribute__((address_space(3)))
typedef unsigned short bf16;
typedef unsigned v4u __attribute__((ext_vector_type(4)));
typedef float f32x4 __attribute__((ext_vector_type(4)));
typedef short bf16x8 __attribute__((ext_vector_type(8)));
typedef GAS unsigned gu32;
typedef GAS unsigned long long gu64;
#define RLX_AGENT __ATOMIC_RELAXED, __HIP_MEMORY_SCOPE_AGENT
#define LDS_WAIT() asm volatile("s_waitcnt lgkmcnt(0)" ::: "memory")
#define VM_WAIT() asm volatile("s_waitcnt vmcnt(0)" ::: "memory")
__device__ __forceinline__ unsigned long long rt() { return __builtin_amdgcn_s_memrealtime(); }
__device__ __forceinline__ unsigned f2bf(float f) { unsigned u = __builtin_bit_cast(unsigned, f); return (u + 0x7fffu + ((u >> 16) & 1u)) >> 16; }
__device__ __forceinline__ unsigned pk2(float lo, float hi) { return f2bf(lo) | (f2bf(hi) << 16); }
#define XB_TMO      128
#define XB_XCNT(j)  (256  + 64 * (j))
#define XB_XSUB(j)  (1280 + 64 * (j))
#define XB_XGEN(j)  (2304 + 64 * (j))
#define XB_TOP      3328
#define XB_TOPGEN   3392
#define XCD_BAR_WORDS 3456
#define XB_SPIN_CAP (1u << 18)

__device__ __forceinline__ unsigned xb_ld(unsigned* p)              { return __hip_atomic_load(p, __ATOMIC_RELAXED, __HIP_MEMORY_SCOPE_AGENT); }
__device__ __forceinline__ unsigned xb_add(unsigned* p, unsigned v) { return __hip_atomic_fetch_add(p, v, __ATOMIC_RELAXED, __HIP_MEMORY_SCOPE_AGENT); }
__device__ __forceinline__ unsigned xb_xcc_id() { return (unsigned)__builtin_amdgcn_s_getreg((3 << 11) | 20) & 0xFu; }
#define XB_SPIN(cond, bar) do { unsigned _sp = 0; while (cond) { __builtin_amdgcn_s_sleep(1); \
    if ((++_sp & 255u) == 0u) { if (xb_ld(&(bar)[XB_TMO])) break; if (_sp > XB_SPIN_CAP) { atomicAdd(&(bar)[XB_TMO], 1u); break; } } } } while (0)

struct XcdBarrier {
    unsigned* bar; unsigned x;
    volatile LAS unsigned* st;
};

__device__ __forceinline__ XcdBarrier xcd_barrier_post(unsigned* bar, volatile LAS unsigned* st) {
    XcdBarrier b; b.bar = bar; b.x = xb_xcc_id(); b.st = st;
    if (threadIdx.x == 0) (void)xb_add(&bar[XB_XCNT(b.x)], 1u);
    return b;
}
__device__ __forceinline__ void xcd_barrier_complete(unsigned* bar, unsigned x, unsigned& nloc, unsigned& nx) {
    const unsigned G = gridDim.x * gridDim.y * gridDim.z;
    unsigned sum, cnt, mine, sp = 0u;
    for (;;) {
        sum = 0u; cnt = 0u; mine = 0u;
#pragma unroll
        for (unsigned j = 0; j < 16; ++j) { const unsigned c = xb_ld(&bar[XB_XCNT(j)]); sum += c; cnt += (c > 0u) ? 1u : 0u; mine = (j == x) ? c : mine; }
        if (sum == G) break;
        __builtin_amdgcn_s_sleep(1);
        if ((++sp & 255u) == 0u) { if (xb_ld(&bar[XB_TMO])) break; if (sp > XB_SPIN_CAP) { atomicAdd(&bar[XB_TMO], 1u); break; } }
    }
    nloc = mine > 0u ? mine : 1u; nx = cnt > 0u ? cnt : 1u;
}

__device__ __forceinline__ void xcd_barrier(const XcdBarrier& b) {
    asm volatile("s_waitcnt vmcnt(0)" ::: "memory");
    __syncthreads();
    if (threadIdx.x == 0) {
        unsigned* bar = b.bar;
        __builtin_amdgcn_s_waitcnt(0);
        unsigned nloc = b.st[0], nx = b.st[1];
        if (nloc == 0u) { xcd_barrier_complete(bar, b.x, nloc, nx); b.st[0] = nloc; b.st[1] = nx; }
        const unsigned old = xb_add(&bar[XB_XSUB(b.x)], 1u);
        const unsigned gen = old / nloc;
        if (old + 1u == (gen + 1u) * nloc) {
            __builtin_amdgcn_fence(__ATOMIC_RELEASE, "agent");
            asm volatile("s_waitcnt vmcnt(0)" ::: "memory");
            const unsigned og = xb_add(&bar[XB_TOP], 1u);
            const unsigned tg = og / nx;
            if (og + 1u == (tg + 1u) * nx) xb_add(&bar[XB_TOPGEN], 1u);
            else XB_SPIN(xb_ld(&bar[XB_TOPGEN]) == tg, bar);
            __builtin_amdgcn_fence(__ATOMIC_ACQUIRE, "agent");
            xb_add(&bar[XB_XGEN(b.x)], 1u);
            asm volatile("s_waitcnt vmcnt(0)" ::: "memory");
        } else {
            XB_SPIN(xb_ld(&bar[XB_XGEN(b.x)]) == gen, bar);
            __builtin_amdgcn_fence(__ATOMIC_ACQUIRE, "agent");
            asm volatile("s_waitcnt vmcnt(0)" ::: "memory");
        }
    }
    __syncthreads();
}
typedef float mk_f32x2 __attribute__((ext_vector_type(2))); typedef __bf16 mk_bf16x2 __attribute__((ext_vector_type(2)));
__device__ __forceinline__ unsigned hpk2(float lo, float hi) { const mk_f32x2 v = {lo, hi}; return __builtin_bit_cast(unsigned, __builtin_convertvector(v, mk_bf16x2)); }
__device__ __forceinline__ unsigned hf2bf(float f) { return hpk2(f, 0.f) & 0xffffu; }
#define pk2 hpk2
#define f2bf hf2bf
constexpr int NWAVES = 8;
constexpr int NB = 16, SEQ = 2048, T = NB * SEQ, DM = 1024, DEPTH = 2;
constexpr int NIN = 2576, N1P = 2816, N1G = 2560, FFN = 2816, NGU = 5632;
constexpr float EPS = 1e-6f;
constexpr float LOG2E = 1.4426950408889634f;
#ifndef PROBE_FLAGS
#define PROBE_FLAGS 0
#endif
#ifndef GLA_RECURRENT
#define GLA_RECURRENT 0
#endif
#ifndef WGM_G1
#define WGM_G1 2
#define WGM_G2 4
#define WGM_G3 4
#define WGM_G4 4
#endif
#ifndef ATT_V2
#define ATT_V2 1
#endif
constexpr size_t MiB = 1u << 20;
constexpr size_t WS_CTL = 0, CTL_ZERO_BYTES = 64 * 1024;
constexpr size_t WS_RSA = 1 * MiB, WS_RSF = 3 * MiB, WS_GLR = 5 * MiB, WS_DEC = 6 * MiB, WS_PWT = 7 * MiB;
constexpr size_t WS_W = 8 * MiB, W_LAYER = 24 * MiB;
constexpr size_t WO_W1 = 0, WO_WO = 5632 * 1024, WO_WGU = WO_WO + 2 * MiB, WO_WD = WO_WGU + 11 * MiB;
static_assert(WO_WD + 5632 * 1024 == W_LAYER, "weights map");
constexpr size_t WS_HB = 56 * MiB;
constexpr size_t WS_Q = 120 * MiB, WS_K = 152 * MiB, WS_V = 184 * MiB;
constexpr size_t WS_GQK = 216 * MiB, WS_GV = 232 * MiB, WS_GR = 248 * MiB, WS_PU = 264 * MiB;
constexpr size_t WS_MIX = 280 * MiB;
constexpr size_t WS_OSCR = 344 * MiB;
constexpr size_t WS_KV = 408 * MiB;
constexpr size_t WS_AG = 424 * MiB;
constexpr size_t WS_FF = 120 * MiB;
constexpr size_t WS_END = 440 * MiB;
constexpr int CW_BAR = 1024;
constexpr int RING_OFF = 0, RING_BYTES = 131072;
constexpr int LDSCTL_OFF = RING_BYTES, MISC_OFF = LDSCTL_OFF + 320;
constexpr int LDS_BYTES = 147456;
constexpr int RST_OFF = LDSCTL_OFF + 1024;
static_assert(RST_OFF + 11 * 256 * 4 <= LDS_BYTES, "row-factor table");
constexpr int ATT_RT_OFF = 102400;
constexpr int ATT_LAM_OFF = ATT_RT_OFF + 4 * 640 * 4;
static_assert(attn_body::ATTN_LDS_BYTES <= ATT_RT_OFF && attn_body::ATTN2_LDS_BYTES <= ATT_RT_OFF && attn_body::ATTN3_LDS_BYTES <= ATT_RT_OFF && ATT_LAM_OFF + 64 <= RING_BYTES, "attention LDS map");

struct Frame {
    LAS unsigned char* lds;
    volatile LAS unsigned* MISC;
    gu32* ctl;
    int tid, lane, wave;
    int vcu, G;
};
struct Args { const float* in[18]; float* out; unsigned char* ws; int ph_lo, ph_hi, flags, bar_region; };
enum { I_X = 0, I_ATTN_G, I_WIN, I_QG, I_KG, I_LV, I_SUBG, I_RELB, I_GGW, I_GGB, I_GNG, I_PW, I_PS, I_WOUT, I_FFN_G, I_WG, I_WU, I_WD };

__device__ __forceinline__ float wave_sum(float v) {
#pragma unroll
    for (int o = 1; o < 64; o <<= 1) v += __shfl_xor(v, o);
    return v;
}
__device__ __forceinline__ float bf2f(bf16 v) { return __builtin_bit_cast(float, (unsigned)v << 16); }
__host__ __device__ __forceinline__ int w1_src_col(int p) {
    if (p >= 2576) return -1;
    if (p >= 2560) return 2048 + (p - 2560);
    const int pn = p >> 8, q = p & 255, bj = q >> 7, wc = (q >> 5) & 3, j = q & 31;
    const int L = 256 * pn + 64 * wc + 32 * bj + j;
    return L < 2048 ? L : L + 16;
}
__device__ __forceinline__ int t5_bucket(int d) {
    if (d < 16) return d;
    const int large = 16 + (int)(logf((float)d / 16.f) / 2.0794415416798357f * 16.f);
    return large < 31 ? large : 31;
}
__device__ __forceinline__ float lam_of(const float* lv, int layer, float& lam_init) {
    float s01 = 0.f, s23 = 0.f;
    for (int i = 0; i < 64; ++i) { s01 += lv[i] * lv[64 + i]; s23 += lv[128 + i] * lv[192 + i]; }
    lam_init = 0.8f - 0.6f * expf(-0.3f * (float)layer);
    return expf(s01) - expf(s23) + lam_init;
}

__device__ __forceinline__ void tr_item(const float* W, int ldw, int srcc, int nvalid, const float* g, int K, bf16* WT, int drow, LAS float* scr, int k0, int lane) {
    { const int n = lane & 31, kh = lane >> 5; float v[32];
#pragma unroll
      for (int i = 0; i < 32; ++i) v[i] = (n < nvalid) ? W[(size_t)(k0 + 2 * i + kh) * ldw + srcc + n] : 0.f;
      if (g) {
#pragma unroll
          for (int i = 0; i < 32; ++i) v[i] *= g[k0 + 2 * i + kh]; }
#pragma unroll
      for (int i = 0; i < 32; ++i) scr[(2 * i + kh) * 33 + n] = v[i]; }
    LDS_WAIT(); asm volatile("" ::: "memory");
    const int c = lane & 7;
#pragma unroll
    for (int j = 0; j < 4; ++j) { const int n = (lane >> 3) + 8 * j; const LAS float* s = scr + (8 * c) * 33 + n;
        v4u o; o.x = pk2(s[0 * 33], s[1 * 33]); o.y = pk2(s[2 * 33], s[3 * 33]); o.z = pk2(s[4 * 33], s[5 * 33]); o.w = pk2(s[6 * 33], s[7 * 33]);
        *(GAS v4u*)(WT + (size_t)(drow + n) * K + k0 + 8 * c) = o; }
    LDS_WAIT(); asm volatile("" ::: "memory");
}
constexpr int P0_I1 = 16 * 88;
__device__ __forceinline__ void p0_weight_items(Frame& F, const Args& a, int it0, int it1, int gw_, int NGW_) {
    LAS float* scr = (LAS float*)(F.lds + RING_OFF + F.wave * 16384);
    constexpr int I1 = P0_I1, I2 = 16 * 32, I3 = 16 * 176, I4 = 44 * 32, IL = I1 + I2 + I3 + I4;
    for (int it = it0 + gw_; it < it1; it += NGW_) {
        const int l = it / IL; int r = it % IL;
        bf16* wl = (bf16*)(a.ws + WS_W + (size_t)l * W_LAYER);
        if (r < I1) { const int kb = r / 88, nb = r % 88, p0 = 32 * nb; int src = 0, nv = 0;
            if (nb < 80) { src = w1_src_col(p0); nv = 32; } else if (nb == 80) { src = 2048; nv = 16; }
            tr_item(a.in[I_WIN] + (size_t)l * DM * NIN, NIN, src, nv, a.in[I_ATTN_G] + l * DM, DM, wl + WO_W1 / 2, p0, scr, 64 * kb, F.lane); continue; }
        r -= I1;
        if (r < I2) { const int kb = r / 32, nb = r % 32;
            tr_item(a.in[I_WOUT] + (size_t)l * DM * DM, DM, 32 * nb, 32, nullptr, DM, wl + WO_WO / 2, 32 * nb, scr, 64 * kb, F.lane); continue; }
        r -= I2;
        if (r < I3) { const int kb = r / 176, nb = r % 176, p0 = 32 * nb, pn = p0 >> 8, bj = (p0 >> 7) & 1, jj = p0 & 127;
            tr_item((bj ? a.in[I_WU] : a.in[I_WG]) + (size_t)l * DM * FFN, FFN, 128 * pn + jj, 32, a.in[I_FFN_G] + l * DM, DM, wl + WO_WGU / 2, p0, scr, 64 * kb, F.lane); continue; }
        r -= I3;
        { const int kb = r / 32, nb = r % 32;
            tr_item(a.in[I_WD] + (size_t)l * FFN * DM, DM, 32 * nb, 32, nullptr, FFN, wl + WO_WD / 2, 32 * nb, scr, 64 * kb, F.lane); }
    }
}
constexpr int P0_ITEMS = DEPTH * (16 * 88 + 16 * 32 + 16 * 176 + 44 * 32);
__device__ __forceinline__ void p0_prologue(Frame& F, const Args& a) {
    const int gw = F.vcu * NWAVES + F.wave, NGW = F.G * NWAVES;
    p0_weight_items(F, a, 0, P0_I1, gw, NGW);
    bf16* HB = (bf16*)(a.ws + WS_HB); float* RSA = (float*)(a.ws + WS_RSA);
    for (int m = gw; m < T; m += 2 * NGW) {
        const int m2 = m + NGW;
        const GAS f32x4* xr = (const GAS f32x4*)(a.in[I_X] + (size_t)m * DM) + F.lane; const GAS f32x4* xr2 = (const GAS f32x4*)(a.in[I_X] + (size_t)(m2 < T ? m2 : m) * DM) + F.lane;
        f32x4 v[4], w[4]; float s = 0.f, s2 = 0.f;
#pragma unroll
        for (int j = 0; j < 4; ++j) { v[j] = xr[64 * j]; w[j] = xr2[64 * j]; }
#pragma unroll
        for (int j = 0; j < 4; ++j) { s += (v[j].x * v[j].x + v[j].y * v[j].y) + (v[j].z * v[j].z + v[j].w * v[j].w); s2 += (w[j].x * w[j].x + w[j].y * w[j].y) + (w[j].z * w[j].z + w[j].w * w[j].w); }
        s = wave_sum(s); s2 = wave_sum(s2);
        GAS unsigned long long* o8 = (GAS unsigned long long*)(HB + (size_t)m * DM) + F.lane;
#pragma unroll
        for (int j = 0; j < 4; ++j) o8[64 * j] = (unsigned long long)pk2(v[j].x, v[j].y) | ((unsigned long long)pk2(v[j].z, v[j].w) << 32);
        if (F.lane < 16) RSA[(size_t)m * 16 + F.lane] = (F.lane == 0) ? s : 0.f;
        if (m2 < T) { GAS unsigned long long* p8 = (GAS unsigned long long*)(HB + (size_t)m2 * DM) + F.lane;
#pragma unroll
            for (int j = 0; j < 4; ++j) p8[64 * j] = (unsigned long long)pk2(w[j].x, w[j].y) | ((unsigned long long)pk2(w[j].z, w[j].w) << 32);
            if (F.lane < 16) RSA[(size_t)m2 * 16 + F.lane] = (F.lane == 0) ? s2 : 0.f; }
    }
    { bf16* PWT = (bf16*)(a.ws + WS_PWT);
      for (int idx = gw * 64 + F.lane; idx < DEPTH * 4 * 64 * 64; idx += NGW * 64) { const int l = idx >> 14, g = (idx >> 12) & 3, dd = (idx >> 6) & 63, c = idx & 63;
          PWT[idx] = (bf16)f2bf(a.in[I_PW][((l * 4 + g) * 64 + c) * 64 + dd] * a.in[I_PS][l * 256 + g * 64 + dd]); } }
}


typedef float f32x16 __attribute__((ext_vector_type(16)));
typedef unsigned long long u64;
constexpr int GLA_TS = 72;
constexpr int GLA_VT_OFF = 32 * GLA_TS * 2;
constexpr int GLA_GW_OFF = GLA_VT_OFF + 64 * GLA_TS * 2;
__device__ __forceinline__ void gla_vt_load(const bf16* GV, size_t row, int h, v4u (&w)[8]) {
    const GAS v4u* vp = (const GAS v4u*)(GV + row * 256 + h * 64);
#pragma unroll
    for (int i = 0; i < 8; ++i) w[i] = vp[i];
}
__device__ __forceinline__ void gla_vt_store(const v4u (&w)[8], int lane, LAS bf16* VT) {
#pragma unroll
    for (int i = 0; i < 8; ++i) { const unsigned ws_[4] = {w[i].x, w[i].y, w[i].z, w[i].w};
#pragma unroll
        for (int k = 0; k < 4; ++k) { VT[(8 * i + 2 * k) * GLA_TS + lane] = (bf16)(ws_[k] & 0xffffu); VT[(8 * i + 2 * k + 1) * GLA_TS + lane] = (bf16)(ws_[k] >> 16); } }
}
__device__ __forceinline__ void gla_lr_partial(const bf16* HBp, const bf16* Wg, int q, int lane, LAS float* slab) {
    const int r = lane & 31, hh = lane >> 5;
    const bf16* a0p = HBp + (size_t)r * DM + 256 * q + 8 * hh; const bf16* a1p = a0p + (size_t)32 * DM; const bf16* bp = Wg + (size_t)(r & 15) * DM + 256 * q + 8 * hh;
    f32x16 d0 = {}, d1 = {};
#pragma unroll
    for (int half = 0; half < 2; ++half) { bf16x8 a0[8], a1[8], bw[8];
#pragma unroll
        for (int s_ = 0; s_ < 8; ++s_) { const int ko = 16 * (8 * half + s_); a0[s_] = *(const GAS bf16x8*)(a0p + ko); a1[s_] = *(const GAS bf16x8*)(a1p + ko); bw[s_] = *(const GAS bf16x8*)(bp + ko); }
#pragma unroll
        for (int s_ = 0; s_ < 8; ++s_) { d0 = __builtin_amdgcn_mfma_f32_32x32x16_bf16(a0[s_], bw[s_], d0, 0, 0, 0); d1 = __builtin_amdgcn_mfma_f32_32x32x16_bf16(a1[s_], bw[s_], d1, 0, 0, 0); } }
    if (r < 16) {
#pragma unroll
        for (int p = 0; p < 16; ++p) { const int m = (p & 3) + 8 * (p >> 2) + 4 * hh; slab[m * 16 + r] = d0[p]; slab[(32 + m) * 16 + r] = d1[p]; } }
}
__device__ __forceinline__ void gla_chunk_A(unsigned char* ws, const float* gw, const float* gb, int c, int lane, LAS unsigned char* scr, const float (&lr)[16]) {
    const int bh = c >> 5, n = c & 31, b = bh >> 2, h = bh & 3;
    const size_t row = (size_t)b * SEQ + n * 64 + lane;
    const bf16* GQK = (const bf16*)(ws + WS_GQK); const bf16* GV = (const bf16*)(ws + WS_GV);
    v4u kw[4], vw[8];
    { const GAS v4u* kp = (const GAS v4u*)(GQK + row * 256 + 128 + h * 32);
#pragma unroll
      for (int i = 0; i < 4; ++i) kw[i] = kp[i]; }
    gla_vt_load(GV, row, h, vw);
    float gwr[8];
#pragma unroll
    for (int i = 0; i < 8; ++i) gwr[i] = gw[(i * 2 + (lane >> 5)) * 128 + h * 32 + (lane & 31)];
    const float gbr = (lane < 32) ? gb[h * 32 + lane] : 0.f;
    asm volatile("" ::: "memory");
    LAS float* gwl = (LAS float*)(scr + GLA_GW_OFF);
#pragma unroll
    for (int i = 0; i < 8; ++i) gwl[i * 64 + lane] = gwr[i];
    if (lane < 32) gwl[512 + lane] = gbr;
    LDS_WAIT(); __builtin_amdgcn_wave_barrier(); asm volatile("" ::: "memory");
    float la[32];
#pragma unroll
    for (int d4 = 0; d4 < 8; ++d4) { const f32x4 b4 = *(const LAS f32x4*)(gwl + 512 + 4 * d4); la[4 * d4] = b4[0]; la[4 * d4 + 1] = b4[1]; la[4 * d4 + 2] = b4[2]; la[4 * d4 + 3] = b4[3]; }
#pragma unroll
    for (int r = 0; r < 16; ++r)
#pragma unroll
        for (int d4 = 0; d4 < 8; ++d4) { const f32x4 w4 = *(const LAS f32x4*)(gwl + r * 32 + 4 * d4);
            la[4 * d4] = fmaf(lr[r], w4[0], la[4 * d4]); la[4 * d4 + 1] = fmaf(lr[r], w4[1], la[4 * d4 + 1]); la[4 * d4 + 2] = fmaf(lr[r], w4[2], la[4 * d4 + 2]); la[4 * d4 + 3] = fmaf(lr[r], w4[3], la[4 * d4 + 3]); }
#pragma unroll
    for (int d = 0; d < 32; ++d) { const float z = la[d]; la[d] = (fminf(z, 0.f) - __logf(1.f + __expf(-fabsf(z)))) * (1.f / 16.f); }
    LAS float* A = (LAS float*)scr;
#pragma unroll
    for (int d4 = 0; d4 < 8; ++d4) *(LAS f32x4*)(A + lane * 36 + 4 * d4) = (f32x4){la[4 * d4], la[4 * d4 + 1], la[4 * d4 + 2], la[4 * d4 + 3]};
    LDS_WAIT(); __builtin_amdgcn_wave_barrier(); asm volatile("" ::: "memory");
    { const int dd = lane & 31, hf = lane >> 5; float v[32];
#pragma unroll
      for (int i = 0; i < 32; ++i) v[i] = A[(32 * hf + i) * 36 + dd];
#pragma unroll
      for (int i = 1; i < 32; ++i) v[i] += v[i - 1];
      const float carry = __shfl_xor(v[31], 32);
      if (hf) {
#pragma unroll
          for (int i = 0; i < 32; ++i) v[i] += carry; }
#pragma unroll
      for (int i = 0; i < 32; ++i) A[(32 * hf + i) * 36 + dd] = v[i]; }
    LDS_WAIT(); __builtin_amdgcn_wave_barrier(); asm volatile("" ::: "memory");
    float Bd[32];
#pragma unroll
    for (int d4 = 0; d4 < 8; ++d4) { const f32x4 a4 = *(const LAS f32x4*)(A + lane * 36 + 4 * d4), b4 = *(const LAS f32x4*)(A + 63 * 36 + 4 * d4);
        la[4 * d4] = a4[0]; la[4 * d4 + 1] = a4[1]; la[4 * d4 + 2] = a4[2]; la[4 * d4 + 3] = a4[3]; Bd[4 * d4] = b4[0]; Bd[4 * d4 + 1] = b4[1]; Bd[4 * d4 + 2] = b4[2]; Bd[4 * d4 + 3] = b4[3]; }
    if (lane < 32) ((float*)(ws + WS_DEC))[(size_t)c * 32 + lane] = __expf(A[63 * 36 + lane]);
    LDS_WAIT(); __builtin_amdgcn_wave_barrier(); asm volatile("" ::: "memory");
    { float* BC = (float*)(ws + WS_AG) + row * 128 + h * 32;
#pragma unroll
      for (int i = 0; i < 8; ++i) *(GAS f32x4*)(BC + 4 * i) = (f32x4){la[4 * i], la[4 * i + 1], la[4 * i + 2], la[4 * i + 3]}; }
    LAS bf16* KeT = (LAS bf16*)scr; LAS bf16* VT = (LAS bf16*)(scr + GLA_VT_OFF);
    {
#pragma unroll
      for (int i = 0; i < 4; ++i) { const v4u w = kw[i]; const unsigned ws_[4] = {w.x, w.y, w.z, w.w};
#pragma unroll
          for (int k = 0; k < 4; ++k) {
#pragma unroll
              for (int e = 0; e < 2; ++e) { const int d = 8 * i + 2 * k + e; const float kv = e ? __builtin_bit_cast(float, ws_[k] & 0xffff0000u) : __builtin_bit_cast(float, ws_[k] << 16);
                  KeT[d * GLA_TS + lane] = (bf16)f2bf(kv * __expf(Bd[d] - la[d])); } } } }
    gla_vt_store(vw, lane, VT);
    LDS_WAIT(); __builtin_amdgcn_wave_barrier(); asm volatile("" ::: "memory");
    const int r = lane & 31, hh = lane >> 5;
    float* KV = (float*)(ws + WS_KV) + (size_t)c * 2048;
#pragma unroll
    for (int vb = 0; vb < 2; ++vb) {
        f32x16 acc = {};
#pragma unroll
        for (int s_ = 0; s_ < 4; ++s_) {
            const bf16x8 A = *(const LAS bf16x8*)(KeT + r * GLA_TS + 16 * s_ + 8 * hh);
            const bf16x8 B = *(const LAS bf16x8*)(VT + (32 * vb + r) * GLA_TS + 16 * s_ + 8 * hh);
            acc = __builtin_amdgcn_mfma_f32_32x32x16_bf16(A, B, acc, 0, 0, 0);
        }
#pragma unroll
        for (int g = 0; g < 4; ++g) *(GAS f32x4*)(KV + ((vb * 4 + g) * 64 + lane) * 4) = (f32x4){acc[4 * g], acc[4 * g + 1], acc[4 * g + 2], acc[4 * g + 3]};
    }
    LDS_WAIT(); __builtin_amdgcn_wave_barrier(); asm volatile("" ::: "memory");
}

constexpr int GLA_SCR = 9216;
constexpr int GLA_SNAP_OFF = NWAVES * GLA_SCR;
__device__ __forceinline__ void gla_state_scan(unsigned char* ws, int c0, int q, int lane, LAS u64* snapall) {
    const int n0 = c0 & 31, cb = c0 - n0, g = q & 3, hh = lane >> 5;
    const float* DEC = (const float*)(ws + WS_DEC) + (size_t)cb * 32 + 8 * g + 4 * hh; const float* KV = (const float*)(ws + WS_KV) + (size_t)cb * 2048 + q * 256 + lane * 4;
    f32x4 S = {0.f, 0.f, 0.f, 0.f};
    for (int jb = 0; jb < n0; jb += 8) {
        f32x4 dq[8], kv[8];
#pragma unroll
        for (int u = 0; u < 8; ++u) { dq[u] = *(const GAS f32x4*)(DEC + (jb + u) * 32); kv[u] = *(const GAS f32x4*)(KV + (size_t)(jb + u) * 2048); }
#pragma unroll
        for (int u = 0; u < 8; ++u) S = S * dq[u] + kv[u];
    }
    {   f32x4 dq[7], kv[7];
#pragma unroll
        for (int u = 0; u < 7; ++u) { dq[u] = *(const GAS f32x4*)(DEC + (n0 + u) * 32); kv[u] = *(const GAS f32x4*)(KV + (size_t)(n0 + u) * 2048); }
#pragma unroll
        for (int u = 0; u < 8; ++u) { snapall[(u * 8 + q) * 64 + lane] = (u64)pk2(S[0], S[1]) | ((u64)pk2(S[2], S[3]) << 32); if (u < 7) S = S * dq[u] + kv[u]; }
    }
}
__device__ __forceinline__ bf16x8 pack8(float a0, float a1, float a2, float a3, float a4, float a5, float a6, float a7) {
    const unsigned w0 = pk2(a0, a1), w1 = pk2(a2, a3), w2 = pk2(a4, a5), w3 = pk2(a6, a7);
    return __builtin_bit_cast(bf16x8, (v4u){w0, w1, w2, w3});
}
__device__ __forceinline__ void gla_chunk_C(unsigned char* ws, const float* gng, int c, int lane, LAS unsigned char* scr, const LAS u64* snap) {
    const int bh = c >> 5, n = c & 31, b = bh >> 2, h = bh & 3, r = lane & 31, hh = lane >> 5;
    const size_t row0 = (size_t)b * SEQ + n * 64;
    const bf16* GQK = (const bf16*)(ws + WS_GQK); const bf16* GV = (const bf16*)(ws + WS_GV); const bf16* GR = (const bf16*)(ws + WS_GR);
    const float* BC = (const float*)(ws + WS_AG); bf16* MIX = (bf16*)(ws + WS_MIX);
    LAS bf16* VT = (LAS bf16*)scr;
    v4u vw[8]; gla_vt_load(GV, row0 + lane, h, vw);
    u64 q4s[2][2][2], k4s[2][2][2]; f32x4 b4s[2][2][2]; u64 g4s[2][2][4];
#pragma unroll
    for (int bj = 0; bj < 2; ++bj) { const size_t trow = row0 + 32 * bj + r;
#pragma unroll
        for (int s_ = 0; s_ < 2; ++s_)
#pragma unroll
            for (int g = 0; g < 2; ++g) { const int d0 = 16 * s_ + 8 * g + 4 * hh;
                q4s[bj][s_][g] = *(const GAS u64*)(GQK + trow * 256 + h * 32 + d0); k4s[bj][s_][g] = *(const GAS u64*)(GQK + trow * 256 + 128 + h * 32 + d0);
                b4s[bj][s_][g] = *(const GAS f32x4*)(BC + trow * 128 + h * 32 + d0); }
#pragma unroll
        for (int vb = 0; vb < 2; ++vb)
#pragma unroll
            for (int g = 0; g < 4; ++g) g4s[bj][vb][g] = *(const GAS u64*)(GR + trow * 256 + h * 64 + 32 * vb + 8 * g + 4 * hh); }
    asm volatile("" ::: "memory");
    gla_vt_store(vw, lane, VT);
    bf16x8 QdF[2][2], KiF[2][2];
    const float scale = 0.17677669529663687f;
#pragma unroll
    for (int bj = 0; bj < 2; ++bj) {
#pragma unroll
        for (int s_ = 0; s_ < 2; ++s_) { float qd[8], ki[8];
#pragma unroll
            for (int g = 0; g < 2; ++g) { const u64 q4 = q4s[bj][s_][g], k4 = k4s[bj][s_][g]; const f32x4 b4 = b4s[bj][s_][g];
#pragma unroll
                for (int x = 0; x < 4; ++x) { const float qv = bf2f((bf16)(q4 >> (16 * x))), kv = bf2f((bf16)(k4 >> (16 * x)));
                    qd[4 * g + x] = qv * scale * __expf(b4[x]); ki[4 * g + x] = kv * __expf(-b4[x]); } }
            QdF[bj][s_] = pack8(qd[0], qd[1], qd[2], qd[3], qd[4], qd[5], qd[6], qd[7]);
            KiF[bj][s_] = pack8(ki[0], ki[1], ki[2], ki[3], ki[4], ki[5], ki[6], ki[7]); } }
    bf16x8 SA[2][2];
#pragma unroll
    for (int vb = 0; vb < 2; ++vb)
#pragma unroll
        for (int s_ = 0; s_ < 2; ++s_) { const u64 lo = snap[(vb * 4 + 2 * s_) * 64 + lane], hi = snap[(vb * 4 + 2 * s_ + 1) * 64 + lane];
            SA[vb][s_] = __builtin_bit_cast(bf16x8, (v4u){(unsigned)lo, (unsigned)(lo >> 32), (unsigned)hi, (unsigned)(hi >> 32)}); }
    f32x16 X00 = {}, X01 = {}, X11 = {};
#pragma unroll
    for (int s_ = 0; s_ < 2; ++s_) { X00 = __builtin_amdgcn_mfma_f32_32x32x16_bf16(KiF[0][s_], QdF[0][s_], X00, 0, 0, 0);
        X01 = __builtin_amdgcn_mfma_f32_32x32x16_bf16(KiF[0][s_], QdF[1][s_], X01, 0, 0, 0); X11 = __builtin_amdgcn_mfma_f32_32x32x16_bf16(KiF[1][s_], QdF[1][s_], X11, 0, 0, 0); }
#pragma unroll
    for (int p = 0; p < 16; ++p) { const int tk = (p & 3) + 8 * (p >> 2) + 4 * hh; if (tk > r) { X00[p] = 0.f; X11[p] = 0.f; } }
    bf16x8 XB00[2], XB01[2], XB11[2];
#pragma unroll
    for (int s_ = 0; s_ < 2; ++s_) { const int o = 8 * s_;
        XB00[s_] = pack8(X00[o], X00[o + 1], X00[o + 2], X00[o + 3], X00[o + 4], X00[o + 5], X00[o + 6], X00[o + 7]);
        XB01[s_] = pack8(X01[o], X01[o + 1], X01[o + 2], X01[o + 3], X01[o + 4], X01[o + 5], X01[o + 6], X01[o + 7]);
        XB11[s_] = pack8(X11[o], X11[o + 1], X11[o + 2], X11[o + 3], X11[o + 4], X11[o + 5], X11[o + 6], X11[o + 7]); }
    LDS_WAIT(); __builtin_amdgcn_wave_barrier(); asm volatile("" ::: "memory");
    f32x16 OT[2][2];
#pragma unroll
    for (int vb = 0; vb < 2; ++vb)
#pragma unroll
        for (int bj = 0; bj < 2; ++bj) { f32x16 o = {};
#pragma unroll
            for (int s_ = 0; s_ < 2; ++s_) o = __builtin_amdgcn_mfma_f32_32x32x16_bf16(SA[vb][s_], QdF[bj][s_], o, 0, 0, 0);
#pragma unroll
            for (int bi = 0; bi <= bj; ++bi)
#pragma unroll
                for (int s_ = 0; s_ < 2; ++s_) { const LAS bf16* p = VT + (32 * vb + r) * GLA_TS + 32 * bi + 16 * s_ + 4 * hh;
                    const u64 lo = *(const LAS u64*)p, hi = *(const LAS u64*)(p + 8);
                    const bf16x8 A = __builtin_bit_cast(bf16x8, (v4u){(unsigned)lo, (unsigned)(lo >> 32), (unsigned)hi, (unsigned)(hi >> 32)});
                    const bf16x8 XB = (bi == 0) ? (bj == 0 ? XB00[s_] : XB01[s_]) : XB11[s_];
                    o = __builtin_amdgcn_mfma_f32_32x32x16_bf16(A, XB, o, 0, 0, 0); }
            OT[vb][bj] = o; }
#pragma unroll
    for (int bj = 0; bj < 2; ++bj) { float ss = 0.f;
#pragma unroll
        for (int vb = 0; vb < 2; ++vb)
#pragma unroll
            for (int p = 0; p < 16; ++p) ss = fmaf(OT[vb][bj][p], OT[vb][bj][p], ss);
        ss += __shfl_xor(ss, 32);
        const float rn = __builtin_amdgcn_rsqf(ss * (1.f / 64.f) + EPS); const size_t trow = row0 + 32 * bj + r;
#pragma unroll
        for (int vb = 0; vb < 2; ++vb)
#pragma unroll
            for (int g = 0; g < 4; ++g) { const int v0 = 32 * vb + 8 * g + 4 * hh;
                const u64 g4 = g4s[bj][vb][g]; const f32x4 n4 = *(const f32x4*)(gng + v0); float o4[4];
#pragma unroll
                for (int x = 0; x < 4; ++x) { const float gr = bf2f((bf16)(g4 >> (16 * x))); o4[x] = OT[vb][bj][4 * g + x] * rn * n4[x] * (gr * __builtin_amdgcn_rcpf(1.f + __expf(-gr))); }
                *(GAS u64*)(MIX + trow * DM + 512 + h * 64 + v0) = (u64)pk2(o4[0], o4[1]) | ((u64)pk2(o4[2], o4[3]) << 32); } }
    LDS_WAIT(); __builtin_amdgcn_wave_barrier(); asm volatile("" ::: "memory");
}
__device__ __forceinline__ void p2a_decay_pool(Frame& F, unsigned char* ws, const float* gw_, const float* gb, int l, const bf16* wglr) {
#if GLA_RECURRENT
    const bf16* GLR = (const bf16*)(ws + WS_GLR); float* AG = (float*)(ws + WS_AG);
    const int gt = F.vcu * (NWAVES * 64) + F.tid, NT_ = F.G * NWAVES * 64;
    for (int idx = gt; idx < T * 128; idx += NT_) {
        const int t = idx >> 7, c = idx & 127;
        float z = gb[c];
#pragma unroll
        for (int r = 0; r < 16; ++r) z = fmaf(bf2f(GLR[(size_t)t * 16 + r]), gw_[r * 128 + c], z);
        const float ls = fminf(z, 0.f) - log1pf(expf(-fabsf(z)));
        AG[idx] = expf(ls * (1.f / 16.f));
    }
#else
    for (int cb = F.vcu; cb < NB * 16; cb += F.G) {
        const int b = cb >> 4, pp = F.wave >> 2, h = F.wave & 3, n = 2 * (cb & 15) + pp; const size_t row0 = (size_t)b * SEQ + n * 64;
        LAS unsigned char* scr = F.lds + RING_OFF + F.wave * 16384;
        const f32x4* rsp = (const f32x4*)((const float*)(ws + WS_RSA) + (row0 + F.lane) * 16); const f32x4 r0 = rsp[0], r1 = rsp[1], r2 = rsp[2], r3 = rsp[3];
        gla_lr_partial((const bf16*)(ws + WS_HB) + row0 * DM, wglr, h, F.lane, (LAS float*)scr);
        LDS_WAIT(); __syncthreads();
        float lr[16];
        { const f32x4 t = (r0 + r1) + (r2 + r3); const float rs = __builtin_amdgcn_rsqf(((t[0] + t[1]) + (t[2] + t[3])) * (1.0f / 1024.0f) + EPS);
          const LAS f32x4* sl = (const LAS f32x4*)(F.lds + RING_OFF + (F.wave & 4) * 16384) + F.lane * 4;
#pragma unroll
          for (int i = 0; i < 4; ++i) { const f32x4 v = ((sl[i] + sl[i + 1024]) + (sl[i + 2048] + sl[i + 3072])) * rs; lr[4 * i] = v[0]; lr[4 * i + 1] = v[1]; lr[4 * i + 2] = v[2]; lr[4 * i + 3] = v[3]; } }
        LDS_WAIT(); __syncthreads();
        gla_chunk_A(ws, gw_, gb, (b * 4 + h) * 32 + n, F.lane, scr, lr);
    }
    __syncthreads();
#endif
    {
        const bf16* PU = (const bf16*)(ws + WS_PU); bf16* MIX = (bf16*)(ws + WS_MIX); const bf16* PWT = (const bf16*)(ws + WS_PWT) + l * 16384;
        constexpr int PS_ = 264;
        LAS bf16* U = (LAS bf16*)(F.lds + RING_OFF); LAS bf16* P = (LAS bf16*)(F.lds + RING_OFF + 80 * PS_ * 2);
        const int g = F.wave >> 1, tb = F.wave & 1, r = F.lane & 31, hh = F.lane >> 5;
        bf16x8 Af[2][4];
#pragma unroll
        for (int ddb = 0; ddb < 2; ++ddb)
#pragma unroll
            for (int s_ = 0; s_ < 4; ++s_) Af[ddb][s_] = *(const GAS bf16x8*)(PWT + (g * 64 + 32 * ddb + r) * 64 + 16 * s_ + 8 * hh);
        v4u un[5];
#define POOL_LOAD(tile_) do { const int t0_ = (tile_) * 64; const bool first_ = (t0_ & (SEQ - 1)) == 0; \
            _Pragma("unroll") for (int i = 0; i < 5; ++i) { const int ch = F.tid + 512 * i, row = ch >> 5, cc = ch & 31; un[i] = (v4u){0u, 0u, 0u, 0u}; \
                if (!(first_ && row < 16)) un[i] = *(const GAS v4u*)(PU + (size_t)(t0_ - 16 + row) * 256 + cc * 8); } } while (0)
        if (F.vcu < T / 64) POOL_LOAD(F.vcu);
        for (int tile = F.vcu; tile < T / 64; tile += F.G) {
            const int t0 = tile * 64;
#pragma unroll
            for (int i = 0; i < 5; ++i) { const int ch = F.tid + 512 * i, row = ch >> 5, cc = ch & 31; *(LAS v4u*)(U + row * PS_ + cc * 8) = un[i]; }
            if (tile + F.G < T / 64) POOL_LOAD(tile + F.G);
            __syncthreads();
            { const int c = F.tid & 255, half = F.tid >> 8, gg = c >> 6, win = 2 << gg; const int s0 = (t0 & (SEQ - 1)) + 32 * half;
              float sum = 0.f;
              for (int j = 1; j < win; ++j) sum += bf2f(U[(16 + 32 * half - j) * PS_ + c]);
              for (int k = 0; k < 32; ++k) { const int tt = 32 * half + k; const float u = bf2f(U[(16 + tt) * PS_ + c]); sum += u;
                  const int cnt = (s0 + k + 1 < win) ? s0 + k + 1 : win;
                  P[tt * PS_ + c] = (bf16)f2bf(sum * __builtin_amdgcn_rcpf((float)cnt) - u); sum -= bf2f(U[(16 + tt - win + 1) * PS_ + c]); } }
            __syncthreads();
            f32x16 acc[2] = {{}, {}};
#pragma unroll
            for (int s_ = 0; s_ < 4; ++s_) { const bf16x8 B = *(const LAS bf16x8*)(P + (32 * tb + r) * PS_ + g * 64 + 16 * s_ + 8 * hh);
#pragma unroll
                for (int ddb = 0; ddb < 2; ++ddb) acc[ddb] = __builtin_amdgcn_mfma_f32_32x32x16_bf16(Af[ddb][s_], B, acc[ddb], 0, 0, 0); }
            bf16* orow = MIX + (size_t)(t0 + 32 * tb + r) * DM + 768 + g * 64 + 4 * hh;
#pragma unroll
            for (int ddb = 0; ddb < 2; ++ddb)
#pragma unroll
                for (int q = 0; q < 4; ++q) *(GAS u64*)(orow + 32 * ddb + 8 * q) = (u64)pk2(acc[ddb][4 * q], acc[ddb][4 * q + 1]) | ((u64)pk2(acc[ddb][4 * q + 2], acc[ddb][4 * q + 3]) << 32);
            __syncthreads();
        }
#undef POOL_LOAD
    }
}

__device__ __forceinline__ unsigned long long ld_sc1_u64(const void* p) { return __hip_atomic_load((const gu64*)p, RLX_AGENT); }
__device__ __forceinline__ void p2b_attention(Frame& F, unsigned char* ws, const float* relb, const float* lv, const float* subg, int l, char* ldsg) {
    LAS float* rt = (LAS float*)(F.lds + ATT_RT_OFF); LAS float* lamp = (LAS float*)(F.lds + ATT_LAM_OFF);
    for (int e = F.tid; e < 4 * 640; e += NWAVES * 64) { const int h = e / 640, j = e % 640, dist = 383 - j;
        float v = 0.f; if (dist < 0) v = -INFINITY; else if (dist < 128) v = (relb[t5_bucket(dist) * 4 + h] - relb[31 * 4 + h]) * LOG2E;
        rt[e] = v; }
    if (F.tid == 0) { float li; const float lam = lam_of(lv, l, li); lamp[0] = lam; lamp[1] = 1.f - li; }
    __syncthreads();
    const float lam = lamp[0], osc = lamp[1];
    const attn_body::bf16* Q = (const attn_body::bf16*)(ws + WS_Q); const attn_body::bf16* K = (const attn_body::bf16*)(ws + WS_K);
    const attn_body::bf16* V = (const attn_body::bf16*)(ws + WS_V); attn_body::bf16* OS = (attn_body::bf16*)(ws + WS_OSCR);
    const bf16* OSr = (const bf16*)(ws + WS_OSCR); bf16* MIX = (bf16*)(ws + WS_MIX);
    for (int pr = F.vcu; pr < 256; pr += F.G) {
        const int bh = pr >> 2, s = pr & 3, b = bh >> 2, h = bh & 3;
        for (int half = 0; half < 2; ++half) {
            const int qb = half ? 7 - s : s;
#if ATT_V2 == 3
            for (int m = 0; m < 2; ++m) attn_body::attn_unit3<0>(b, qb, Q + (h * 2 + m) * 64, K + (h * 2 + m) * 64, V + h * 128, OS + h * 256 + m * 128, ldsg, rt + h * 640);
#elif ATT_V2
            for (int m = 0; m < 2; ++m) attn_body::attn_unit2<0>(b, qb, Q + (h * 2 + m) * 64, K + (h * 2 + m) * 64, V + h * 128, OS + h * 256 + m * 128, ldsg, rt + h * 640);
#else
            for (int sub = 0; sub < 4; ++sub) { const int m = sub >> 1, vh = sub & 1;
                attn_body::attn_unit<8>(b, qb, Q + (h * 2 + m) * 64, K + (h * 2 + m) * 64, V + h * 128 + vh * 64, OS + h * 256 + m * 128 + vh * 64, ldsg, rt + h * 640); }
#endif
            VM_WAIT(); __syncthreads();
            const size_t row0 = (size_t)b * SEQ + qb * 256 + F.wave * 32;
            { const int c8 = (F.lane & 15) * 8; unsigned long long ld[8][4];
#pragma unroll
              for (int it = 0; it < 8; ++it) { const bf16* p0 = OSr + (row0 + it * 4 + (F.lane >> 4)) * 1024 + h * 256 + c8;
                  ld[it][0] = ld_sc1_u64(p0); ld[it][1] = ld_sc1_u64(p0 + 4); ld[it][2] = ld_sc1_u64(p0 + 128); ld[it][3] = ld_sc1_u64(p0 + 132); }
              const f32x4 g0 = *(const f32x4*)(subg + c8), g1 = *(const f32x4*)(subg + c8 + 4);
#pragma unroll
              for (int it = 0; it < 8; ++it) {
                const size_t row = row0 + it * 4 + (F.lane >> 4);
                const unsigned long long a0 = ld[it][0], a1 = ld[it][1], b0 = ld[it][2], b1 = ld[it][3];
                float d[8]; float ss = 0.f;
#pragma unroll
                for (int i = 0; i < 4; ++i) { d[i] = bf2f((bf16)(a0 >> (16 * i))) - lam * bf2f((bf16)(b0 >> (16 * i))); d[4 + i] = bf2f((bf16)(a1 >> (16 * i))) - lam * bf2f((bf16)(b1 >> (16 * i))); }
#pragma unroll
                for (int i = 0; i < 8; ++i) ss += d[i] * d[i];
                ss += __shfl_xor(ss, 1); ss += __shfl_xor(ss, 2); ss += __shfl_xor(ss, 4); ss += __shfl_xor(ss, 8);
                const float rn = osc * __builtin_amdgcn_rsqf(ss * (1.f / 128.f) + EPS);
                v4u o; o.x = pk2(d[0] * rn * g0[0], d[1] * rn * g0[1]); o.y = pk2(d[2] * rn * g0[2], d[3] * rn * g0[3]); o.z = pk2(d[4] * rn * g1[0], d[5] * rn * g1[1]); o.w = pk2(d[6] * rn * g1[2], d[7] * rn * g1[3]);
                *(GAS v4u*)(MIX + row * DM + h * 128 + c8) = o;
              } }
        }
    }
}
__device__ __forceinline__ void gla_recurrent(unsigned char* ws, const float* gng, int bh, int lane) {
    const int b = bh >> 2, h = bh & 3;
    const bf16* __restrict__ GQK = (const bf16*)(ws + WS_GQK); const bf16* __restrict__ GV = (const bf16*)(ws + WS_GV); const bf16* __restrict__ GR = (const bf16*)(ws + WS_GR);
    const float* __restrict__ AG = (const float*)(ws + WS_AG); bf16* __restrict__ MIX = (bf16*)(ws + WS_MIX);
    const float ng = gng[lane];
    float st[32];
#pragma unroll
    for (int d = 0; d < 32; ++d) st[d] = 0.f;
    const float scale = 0.17677669529663687f;
    for (int t = 0; t < SEQ; ++t) {
        const size_t row = (size_t)b * SEQ + t;
        const float v = bf2f(GV[row * 256 + h * 64 + lane]);
        const bf16* qp = GQK + row * 256 + h * 32; const bf16* kp = qp + 128; const float* ap = AG + row * 128 + h * 32;
        float o = 0.f;
#pragma unroll
        for (int d = 0; d < 32; ++d) { st[d] = fmaf(ap[d], st[d], bf2f(kp[d]) * v); o = fmaf(bf2f(qp[d]), st[d], o); }
        o *= scale;
        const float r = 1.0f / sqrtf(wave_sum(o * o) * (1.f / 64.f) + EPS);
        const float gr = bf2f(GR[row * 256 + h * 64 + lane]);
        MIX[row * DM + 512 + h * 64 + lane] = (bf16)f2bf(o * r * ng * (gr / (1.f + expf(-gr))));
    }
}

constexpr int NPH = 1 + 6 * DEPTH;
constexpr int FLAG_SKIP_ATTN = 1;
__global__ void __launch_bounds__(NWAVES * 64, 2) mk_fwd(Args args) {
    extern __shared__ __attribute__((aligned(16))) unsigned char lds[];
    Frame F;
#define PHASE_BEGIN() int tid_ = threadIdx.x; asm volatile("" : "+v"(tid_)); F.tid = tid_; F.lane = tid_ & 63; F.wave = __builtin_amdgcn_readfirstlane(tid_ >> 6); \
    unsigned long long z_ = 0; asm volatile("" : "+s"(z_)); unsigned char* ws = args.ws + z_
    F.lds = (LAS unsigned char*)lds;
    F.MISC = (volatile LAS unsigned*)(F.lds + MISC_OFF);
    F.G = gridDim.x; { const int bx = blockIdx.x; F.vcu = (F.G % 8 == 0) ? (bx % 8) * (F.G / 8) + bx / 8 : bx; }
    F.ctl = (gu32*)(args.ws + WS_CTL);
    for (int u = threadIdx.x; u < (LDS_BYTES - LDSCTL_OFF) / 4; u += NWAVES * 64) ((LAS unsigned*)(F.lds + LDSCTL_OFF))[u] = 0u;
    __syncthreads();
    const int lo = args.ph_lo, hi = args.ph_hi;
    XcdBarrier bar; bar.bar = (unsigned*)(F.ctl + CW_BAR) + args.bar_region * XCD_BAR_WORDS; bar.x = 0; bar.st = nullptr;
    if (hi - lo > 1) bar = xcd_barrier_post((unsigned*)(F.ctl + CW_BAR) + args.bar_region * XCD_BAR_WORDS, F.MISC + 8);
#define IN(k) (lo <= (k) && (k) < hi)
#define SEAM(k) do { if (IN(k) && IN((k) + 1)) xcd_barrier(bar); } while (0)
#ifndef NO_P0
    if (IN(0)) { PHASE_BEGIN(); (void)ws; p0_prologue(F, args); SEAM(0);
        if (PROBE_FLAGS & 8) { for (int rep = 0; rep < 8; ++rep) SEAM(0); } }
#endif
    for (int l = 0; l < DEPTH; ++l) {
        const int pb = 1 + 6 * l;
#ifndef NO_G1
        if (IN(pb + 0)) {
            PHASE_BEGIN(); bf16* wl = (bf16*)(ws + WS_W + (size_t)l * W_LAYER);
            pg8::Gemm g{(const bf16*)(ws + WS_HB), wl + WO_W1 / 2, T, N1G, DM}; pg8::StaticOrder S; S.init(T, N1G, F.G, (int)blockIdx.x, WGM_G1);
            LAS float* rst = (LAS float*)(F.lds + RST_OFF); pg8::rs_table_fill(rst, (const float*)(ws + WS_RSA), S, tid_);
            pg8::EpiProj E{rst, (bf16*)(ws + WS_Q), (bf16*)(ws + WS_K), (bf16*)(ws + WS_V), (bf16*)(ws + WS_GQK), (bf16*)(ws + WS_GLR),
                           args.in[I_QG] + l * 64, args.in[I_KG] + l * 64, attn_body::C2};
            pg8::gemm_phase<pg8::EpiProj, pg8::StaticOrder, true, true>(F.lds + RING_OFF, g, S, E);
            {
                const int nfull = ((T / 256) * (N1G / 256)) % F.G, bx = (int)blockIdx.x; constexpr int IL = P0_ITEMS / DEPTH;
                const int it0 = l * IL + P0_I1, it1 = (l + 1 < DEPTH) ? (l + 1) * IL + P0_I1 : DEPTH * IL;
                if (bx >= nfull) p0_weight_items(F, args, it0, it1, (bx - nfull) * NWAVES + F.wave, (F.G - nfull) * NWAVES);
            }
            SEAM(pb + 0);
        }
#endif
#ifndef NO_P2A
        if (IN(pb + 1)) { PHASE_BEGIN(); p2a_decay_pool(F, ws, args.in[I_GGW] + l * 16 * 128, args.in[I_GGB] + l * 128, l, (const bf16*)(ws + WS_W + (size_t)l * W_LAYER) + WO_W1 / 2 + (size_t)N1G * DM); SEAM(pb + 1); }
#endif
        if (IN(pb + 2)) {
            PHASE_BEGIN();
#ifndef NO_GLA
#if GLA_RECURRENT
            if (F.wave == 0 && F.vcu < NB * 4) gla_recurrent(ws, args.in[I_GNG] + l * 64, F.vcu, F.lane);
#else
            for (int rep = 0; rep < ((PROBE_FLAGS & 2) ? 2 : 1); ++rep)
            for (int cg = F.vcu; cg < NB * 4 * 4; cg += F.G) {
                LAS u64* snapall = (LAS u64*)(F.lds + RING_OFF + GLA_SNAP_OFF);
                gla_state_scan(ws, cg * 8, F.wave, F.lane, snapall);
                LDS_WAIT(); __syncthreads();
                gla_chunk_C(ws, args.in[I_GNG] + l * 64, cg * 8 + F.wave, F.lane, F.lds + RING_OFF + F.wave * GLA_SCR, snapall + F.wave * 512);
                __syncthreads();
            }
#endif
#endif
#ifndef NO_ATT
            if (!(args.flags & FLAG_SKIP_ATTN)) for (int rep = 0; rep < ((PROBE_FLAGS & 4) ? 2 : 1); ++rep) p2b_attention(F, ws, args.in[I_RELB], args.in[I_LV] + l * 256, args.in[I_SUBG] + l * 128, l, (char*)lds + RING_OFF);
#endif
            SEAM(pb + 2);
        }
#ifndef NO_G2
        if (IN(pb + 3)) {
            PHASE_BEGIN(); bf16* wl = (bf16*)(ws + WS_W + (size_t)l * W_LAYER);
            pg8::Gemm g{(const bf16*)(ws + WS_MIX), wl + WO_WO / 2, T, DM, DM}; pg8::StaticOrder S; S.init(T, DM, F.G, (int)blockIdx.x, WGM_G2);
            pg8::EpiRes<false> E{args.out, (bf16*)(ws + WS_HB), (float*)(ws + WS_RSF)};
            pg8::gemm_phase<pg8::EpiRes<false>, pg8::StaticOrder, true, true>(F.lds + RING_OFF, g, S, E);
            SEAM(pb + 3);
        }
#endif
#ifndef NO_G3
        if (IN(pb + 4)) {
            PHASE_BEGIN(); bf16* wl = (bf16*)(ws + WS_W + (size_t)l * W_LAYER);
            pg8::Gemm g{(const bf16*)(ws + WS_HB), wl + WO_WGU / 2, T, NGU, DM}; pg8::StaticOrder S; S.init(T, NGU, F.G, (int)blockIdx.x, WGM_G3);
            LAS float* rst = (LAS float*)(F.lds + RST_OFF); pg8::rs_table_fill(rst, (const float*)(ws + WS_RSF), S, tid_);
            pg8::EpiGU E{rst, (bf16*)(ws + WS_FF)};
            pg8::gemm_phase<pg8::EpiGU, pg8::StaticOrder, true, true>(F.lds + RING_OFF, g, S, E);
            SEAM(pb + 4);
        }
#endif
#ifndef NO_G4
        if (IN(pb + 5)) {
            PHASE_BEGIN(); bf16* wl = (bf16*)(ws + WS_W + (size_t)l * W_LAYER);
            pg8::Gemm g{(const bf16*)(ws + WS_FF), wl + WO_WD / 2, T, DM, FFN}; pg8::StaticOrder S; S.init(T, DM, F.G, (int)blockIdx.x, WGM_G4);
            if (l == DEPTH - 1) { pg8::EpiRes<true> E{args.out, (bf16*)(ws + WS_HB), (float*)(ws + WS_RSA)};
                pg8::gemm_phase<pg8::EpiRes<true>, pg8::StaticOrder, true, true>(F.lds + RING_OFF, g, S, E); }
            else { pg8::EpiRes<false> E{args.out, (bf16*)(ws + WS_HB), (float*)(ws + WS_RSA)};
                pg8::gemm_phase<pg8::EpiRes<false>, pg8::StaticOrder, true, true>(F.lds + RING_OFF, g, S, E); }
            SEAM(pb + 5);
        }
#endif
    }
#undef IN
#undef SEAM
#undef PHASE_BEGIN
}

#ifndef PROBE_DUP
#define PROBE_DUP (-1)
#endif
#ifndef MK_FAST
#define MK_FAST 0x1fff
#endif
#if MK_FAST != 0x1fff
namespace sk {
__device__ __forceinline__ float wsum(float v) {
#pragma unroll
    for (int o = 1; o < 64; o <<= 1) v += __shfl_xor(v, o);
    return v;
}
__device__ __forceinline__ float wmax(float v) {
#pragma unroll
    for (int o = 1; o < 64; o <<= 1) v = fmaxf(v, __shfl_xor(v, o));
    return v;
}
__device__ __forceinline__ float dot_bf16(const bf16* a, const bf16* b, int K) {
    float s = 0.f;
    for (int k = 0; k < K; k += 8) { const v4u x = *(const v4u*)(a + k), y = *(const v4u*)(b + k);
        const unsigned xs[4] = {x.x, x.y, x.z, x.w}, ys[4] = {y.x, y.y, y.z, y.w};
#pragma unroll
        for (int i = 0; i < 4; ++i) { s = fmaf(__builtin_bit_cast(float, xs[i] << 16), __builtin_bit_cast(float, ys[i] << 16), s);
            s = fmaf(__builtin_bit_cast(float, xs[i] & 0xffff0000u), __builtin_bit_cast(float, ys[i] & 0xffff0000u), s); } }
    return s;
}
__device__ __forceinline__ float rs_of(const float* rowsq, int row) { float s = 0.f; for (int i = 0; i < 16; ++i) s += rowsq[(size_t)row * 16 + i]; return 1.0f / sqrtf(s * (1.f / 1024.f) + EPS); }
__global__ void __launch_bounds__(256) p0_weights(Args a) {
    const size_t per_layer = (size_t)(N1P + DM + NGU) * DM + (size_t)DM * FFN;
    for (size_t idx = (size_t)blockIdx.x * 256 + threadIdx.x; idx < DEPTH * per_layer; idx += (size_t)gridDim.x * 256) {
        const int l = (int)(idx / per_layer); size_t r = idx % per_layer;
        bf16* wl = (bf16*)(a.ws + WS_W + (size_t)l * W_LAYER);
        if (r < (size_t)N1P * DM) { const int p = (int)(r / DM), k = (int)(r % DM); const int c = w1_src_col(p);
            const float v = c < 0 ? 0.f : a.in[I_WIN][(size_t)l * DM * NIN + (size_t)k * NIN + c] * a.in[I_ATTN_G][l * DM + k];
            wl[WO_W1 / 2 + r] = (bf16)f2bf(v); continue; }
        r -= (size_t)N1P * DM;
        if (r < (size_t)DM * DM) { const int n = (int)(r / DM), k = (int)(r % DM); wl[WO_WO / 2 + r] = (bf16)f2bf(a.in[I_WOUT][(size_t)l * DM * DM + (size_t)k * DM + n]); continue; }
        r -= (size_t)DM * DM;
        if (r < (size_t)NGU * DM) { const int p = (int)(r / DM), k = (int)(r % DM), pn = p >> 8, bj = (p >> 7) & 1, jj = p & 127;
            const float v = (bj ? a.in[I_WU] : a.in[I_WG])[(size_t)l * DM * FFN + (size_t)k * FFN + 128 * pn + jj] * a.in[I_FFN_G][l * DM + k];
            wl[WO_WGU / 2 + r] = (bf16)f2bf(v); continue; }
        r -= (size_t)NGU * DM;
        { const int n = (int)(r / FFN), k = (int)(r % FFN); wl[WO_WD / 2 + r] = (bf16)f2bf(a.in[I_WD][(size_t)l * FFN * DM + (size_t)k * DM + n]); }
    }
}
__global__ void __launch_bounds__(256) p0_rows(Args a) {
    const int row = blockIdx.x * 4 + (threadIdx.x >> 6), lane = threadIdx.x & 63;
    bf16* HB = (bf16*)(a.ws + WS_HB); float* RSA = (float*)(a.ws + WS_RSA);
    float s = 0.f;
    for (int c = lane; c < DM; c += 64) { const float v = a.in[I_X][(size_t)row * DM + c]; s += v * v; HB[(size_t)row * DM + c] = (bf16)f2bf(v); }
    s = wsum(s);
    if (lane < 16) RSA[(size_t)row * 16 + lane] = lane == 0 ? s : 0.f;
}
__global__ void __launch_bounds__(256) gemm1(Args a, int l) {
    const int gwv = blockIdx.x * 4 + (threadIdx.x >> 6), lane = threadIdx.x & 63;
    const int row = gwv / 41, grp = gwv % 41;
    const bf16* HB = (const bf16*)(a.ws + WS_HB); const bf16* W1 = (const bf16*)(a.ws + WS_W + (size_t)l * W_LAYER + WO_W1);
    int p;
    if (grp < 40) { const int L = grp * 64 + lane; p = 256 * (L >> 8) + 128 * ((L >> 5) & 1) + 32 * ((L >> 6) & 3) + (L & 31); } else p = 2560 + (lane & 15);
    const float val = dot_bf16(HB + (size_t)row * DM, W1 + (size_t)p * DM, DM) * rs_of((const float*)(a.ws + WS_RSA), row);
    if (grp < 16) { const float rn = 1.0f / sqrtf(wsum(val * val) * (1.f / 64.f) + EPS);
        if (grp < 8) ((bf16*)(a.ws + WS_Q))[(size_t)row * 512 + grp * 64 + lane] = (bf16)f2bf(val * rn * a.in[I_QG][l * 64 + lane] * attn_body::C2);
        else ((bf16*)(a.ws + WS_K))[(size_t)row * 512 + (grp - 8) * 64 + lane] = (bf16)f2bf(val * rn * a.in[I_KG][l * 64 + lane]); }
    else if (grp < 24) ((bf16*)(a.ws + WS_V))[(size_t)row * 512 + (grp - 16) * 64 + lane] = (bf16)f2bf(val);
    else if (grp < 28) ((bf16*)(a.ws + WS_GQK))[(size_t)row * 256 + (grp - 24) * 64 + lane] = (bf16)f2bf(val);
    else if (grp < 32) ((bf16*)(a.ws + WS_GV))[(size_t)row * 256 + (grp - 28) * 64 + lane] = (bf16)f2bf(val);
    else if (grp < 36) ((bf16*)(a.ws + WS_GR))[(size_t)row * 256 + (grp - 32) * 64 + lane] = (bf16)f2bf(val);
    else if (grp < 40) ((bf16*)(a.ws + WS_PU))[(size_t)row * 256 + (grp - 36) * 64 + lane] = (bf16)f2bf(val);
    else if (grp == 40 && lane < 16) ((bf16*)(a.ws + WS_GLR))[(size_t)row * 16 + lane] = (bf16)f2bf(val);
}
__global__ void __launch_bounds__(256) gemm_res(Args a, const bf16* A, const bf16* Bt, int K, float* rowsq_out, int final_) {
    const int gwv = blockIdx.x * 4 + (threadIdx.x >> 6), lane = threadIdx.x & 63;
    const int row = gwv >> 4, ch = gwv & 15, c = ch * 64 + lane;
    bf16* HB = (bf16*)(a.ws + WS_HB);
    const float h = bf2f(HB[(size_t)row * DM + c]) + dot_bf16(A + (size_t)row * K, Bt + (size_t)c * K, K);
    if (final_) { a.out[(size_t)row * DM + c] = h; return; }
    HB[(size_t)row * DM + c] = (bf16)f2bf(h);
    const float ss = wsum(h * h);
    if (lane == 0) rowsq_out[(size_t)row * 16 + ch] = ss;
}
__global__ void __launch_bounds__(256) gemm3(Args a, int l) {
    const int gwv = blockIdx.x * 4 + (threadIdx.x >> 6), lane = threadIdx.x & 63;
    const int row = gwv / 44, c = (gwv % 44) * 64 + lane, pn = c >> 7, jj = c & 127;
    const bf16* HB = (const bf16*)(a.ws + WS_HB); const bf16* W = (const bf16*)(a.ws + WS_W + (size_t)l * W_LAYER + WO_WGU);
    const float r = rs_of((const float*)(a.ws + WS_RSF), row);
    const float g = dot_bf16(HB + (size_t)row * DM, W + (size_t)(256 * pn + jj) * DM, DM) * r, u = dot_bf16(HB + (size_t)row * DM, W + (size_t)(256 * pn + 128 + jj) * DM, DM) * r;
    ((bf16*)(a.ws + WS_FF))[(size_t)row * FFN + c] = (bf16)f2bf(g / (1.f + expf(-g)) * u);
}
__global__ void __launch_bounds__(128) attn(Args a, int l) {
    __shared__ float sc[2][2][SEQ];
    __shared__ float biasd[SEQ];
    const int wv = threadIdx.x >> 6, lane = threadIdx.x & 63;
    const int h = blockIdx.y, b = blockIdx.z, q = blockIdx.x * 2 + wv;
    for (int d = threadIdx.x; d < SEQ; d += 128) biasd[d] = a.in[I_RELB][t5_bucket(d) * 4 + h] * LOG2E;
    __syncthreads();
    float lam_init; const float lam = lam_of(a.in[I_LV] + l * 256, l, lam_init);
    const bf16* Q = (const bf16*)(a.ws + WS_Q); const bf16* K = (const bf16*)(a.ws + WS_K); const bf16* V = (const bf16*)(a.ws + WS_V);
    float lsum[2];
    for (int m = 0; m < 2; ++m) {
        const bf16* qp = Q + (size_t)(b * SEQ + q) * 512 + (h * 2 + m) * 64;
        float mx = -1e30f;
        for (int k = lane; k <= q; k += 64) {
            const float s = dot_bf16(qp, K + (size_t)(b * SEQ + k) * 512 + (h * 2 + m) * 64, 64) + biasd[q - k];
            sc[wv][m][k] = s; mx = fmaxf(mx, s);
        }
        mx = wmax(mx);
        float sum = 0.f;
        for (int k = lane; k <= q; k += 64) { const float p = exp2f(sc[wv][m][k] - mx); sc[wv][m][k] = p; sum += p; }
        lsum[m] = wsum(sum);
    }
    const float i0 = 1.f / lsum[0], i1 = lam / lsum[1];
    for (int k = lane; k <= q; k += 64) sc[wv][0][k] = sc[wv][0][k] * i0 - sc[wv][1][k] * i1;
    __builtin_amdgcn_s_waitcnt(0);
    __builtin_amdgcn_wave_barrier();
    float o0 = 0.f, o1 = 0.f;
    const bf16* vp = V + (size_t)(b * SEQ) * 512 + h * 128 + lane;
    for (int k = 0; k <= q; ++k) { const float w = sc[wv][0][k]; o0 = fmaf(w, bf2f(vp[(size_t)k * 512]), o0); o1 = fmaf(w, bf2f(vp[(size_t)k * 512 + 64]), o1); }
    const float r = 1.0f / sqrtf(wsum(o0 * o0 + o1 * o1) * (1.f / 128.f) + EPS) * (1.f - lam_init);
    bf16* mp = (bf16*)(a.ws + WS_MIX) + (size_t)(b * SEQ + q) * DM + h * 128 + lane;
    mp[0] = (bf16)f2bf(o0 * r * a.in[I_SUBG][l * 128 + lane]); mp[64] = (bf16)f2bf(o1 * r * a.in[I_SUBG][l * 128 + lane + 64]);
}
}
#endif

extern "C" void kernel_launch(void* const* d_in, const int* in_sizes, int n_in, void* d_out, int out_size, void* d_ws, size_t ws_size, hipStream_t stream) {
    static int grid = 0;
    if (grid == 0) {
        if (n_in != 18 || in_sizes[0] != T * DM || out_size != T * DM || ws_size < WS_END) { fprintf(stderr, "kernel_launch: unexpected shapes / workspace (n_in %d, ws %zu)\n", n_in, ws_size); grid = -1; return; }
        int dev = 0, cus = 0, per_cu = 0;
        if (hipGetDevice(&dev) != hipSuccess || hipDeviceGetAttribute(&cus, hipDeviceAttributeMultiprocessorCount, dev) != hipSuccess) { grid = -1; return; }
        if (hipFuncSetAttribute((const void*)mk_fwd, hipFuncAttributeMaxDynamicSharedMemorySize, LDS_BYTES) != hipSuccess) { fprintf(stderr, "kernel_launch: hipFuncSetAttribute failed\n"); grid = -1; return; }
        if (hipOccupancyMaxActiveBlocksPerMultiprocessor(&per_cu, (const void*)mk_fwd, NWAVES * 64, LDS_BYTES) != hipSuccess || per_cu < 1) { fprintf(stderr, "kernel_launch: occupancy query says %d blocks per CU\n", per_cu); (void)hipGetLastError(); per_cu = 1; }
        grid = cus;
    }
    if (grid < 0) return;
    (void)hipMemsetAsync((char*)d_ws + WS_CTL, 0, CTL_ZERO_BYTES, stream);
    Args a{};
    for (int i = 0; i < 18; ++i) a.in[i] = (const float*)d_in[i];
    a.out = (float*)d_out; a.ws = (unsigned char*)d_ws;
#if MK_FAST == 0x1fff
    a.ph_lo = 0; a.ph_hi = NPH; a.flags = 0;
    void* kargs[] = {&a};
#if PROBE_DUP >= 0
    a.ph_hi = PROBE_DUP + 1; (void)hipLaunchCooperativeKernel((const void*)mk_fwd, dim3(grid), dim3(NWAVES * 64), kargs, LDS_BYTES, stream);
    a.ph_lo = PROBE_DUP; a.ph_hi = NPH; a.bar_region = 1;
#endif
    hipError_t e = hipLaunchCooperativeKernel((const void*)mk_fwd, dim3(grid), dim3(NWAVES * 64), kargs, LDS_BYTES, stream);
    if (e != hipSuccess) fprintf(stderr, "kernel_launch: cooperative launch failed: %s (grid %d)\n", hipGetErrorString(e), grid);
#else
    auto run_fast = [&](int p, int flags) { Args b = a; b.ph_lo = p; b.ph_hi = p + 1; b.flags = flags; hipLaunchKernelGGL(mk_fwd, dim3(grid), dim3(NWAVES * 64), LDS_BYTES, stream, b); };
    const unsigned fast = MK_FAST;
    unsigned char* ws = (unsigned char*)d_ws;
    if (fast & 1u) run_fast(0, 0); else { sk::p0_weights<<<4096, 256, 0, stream>>>(a); sk::p0_rows<<<T / 4, 256, 0, stream>>>(a); }
    for (int l = 0; l < DEPTH; ++l) {
        const int pb = 1 + 6 * l;
        const bf16* wl = (const bf16*)(ws + WS_W + (size_t)l * W_LAYER);
        if (fast & (1u << (pb + 0))) run_fast(pb + 0, 0); else { sk::p0_weights<<<4096, 256, 0, stream>>>(a);
            sk::gemm1<<<T * 41 / 4, 256, 0, stream>>>(a, l); }
        run_fast(pb + 1, 0);
        if (fast & (1u << (pb + 2))) run_fast(pb + 2, 0); else { sk::attn<<<dim3(SEQ / 2, 4, NB), 128, 0, stream>>>(a, l); run_fast(pb + 2, FLAG_SKIP_ATTN); }
        if (fast & (1u << (pb + 3))) run_fast(pb + 3, 0); else sk::gemm_res<<<T * 16 / 4, 256, 0, stream>>>(a, (const bf16*)(ws + WS_MIX), wl + WO_WO / 2, DM, (float*)(ws + WS_RSF), 0);
        if (fast & (1u << (pb + 4))) run_fast(pb + 4, 0); else sk::gemm3<<<T * 44 / 4, 256, 0, stream>>>(a, l);
        if (fast & (1u << (pb + 5))) run_fast(pb + 5, 0); else sk::gemm_res<<<T * 16 / 4, 256, 0, stream>>>(a, (const bf16*)(ws + WS_FF), wl + WO_WD / 2, FFN, (float*)(ws + WS_RSA), l == DEPTH - 1);
    }
#endif
}
```

```cpp
#include <hip/hip_runtime.h>
#include <hip/hip_bf16.h>
#include <cstdio>
#include <cstdint>
#include <cmath>
#ifndef MK_ALIGN_GEMM
#define MK_ALIGN_GEMM ".p2align 6"
#endif
#ifndef MK_ALIGN_MMA
#define MK_ALIGN_MMA ".p2align 3"
#endif
#ifndef MK_ALIGN_ATT
#define MK_ALIGN_ATT ".p2align 6"
#endif
namespace pg8 {
#define PG8_LAS __attribute__((address_space(3)))
typedef unsigned short bf16_t;
typedef short bf16x8 __attribute__((ext_vector_type(8)));
typedef float f32x4 __attribute__((ext_vector_type(4)));
typedef unsigned u32x4 __attribute__((ext_vector_type(4)));
constexpr int BM = 256, BK = 64, HALF = 128, HTB = HALF * BK * 2  , STAGE_BYTES = 8 * HTB, NXCD = 8, WGM = 8;

__host__ __device__ __forceinline__ int lds_byte(int r, int c) { const int st = (r >> 4) * 2 + (c >> 5), rr = r & 15, cc = c & 31, ob = rr * 64 + cc * 2; return st * 1024 + (ob ^ (((ob >> 9) & 1) << 5)); }
__host__ __device__ __forceinline__ void stage_rc(int b, int& R, int& C) { const int st = b / 1024, sb = b % 1024, swz = sb ^ (((sb >> 9) & 1) << 5); R = (st >> 1) * 16 + swz / 64; C = (st & 1) * 32 + (swz % 64) / 2; }
__host__ __device__ __forceinline__ int perm32(int rho) { const int n = rho >> 4, i = rho & 15; return 8 * (i >> 2) + 4 * n + (i & 3); }

struct Unit { int pm, pn, ui; };
struct Gemm { const bf16_t* A; const bf16_t* Bt; int M, N, K; };

struct StaticOrder {
    int nM, nN, nwg, G, c, wgm;
    __host__ __device__ void init(int M, int N, int G_, int c_, int wgm_ = 4) { nM = M / BM; nN = N / BM; nwg = nM * nN; G = G_; c = c_; wgm = wgm_; }
    __host__ __device__ bool next(int i, Unit& u) const {
        const long L = (long)i * G + c; if (L >= nwg) return false;
        int wgid = (int)L; { const int q = nwg / NXCD, r = nwg % NXCD, xcd = wgid % NXCD, off = wgid / NXCD; wgid = (xcd < r ? xcd * (q + 1) : r * (q + 1) + (xcd - r) * q) + off; }
        const int nig = wgm * nN, gid = wgid / nig, fm = gid * wgm, gsz = (nM - fm) < wgm ? (nM - fm) : wgm;
        u.pm = fm + ((wgid % nig) % gsz); u.pn = (wgid % nig) / gsz; u.ui = i; return true;
    }
    __device__ __forceinline__ void a_ready(const Unit&) const {}
    __device__ __forceinline__ void done(const Unit&) const {}
};
__device__ __forceinline__ unsigned cvt_pk_bf16(float lo, float hi) { unsigned r; asm volatile("v_cvt_pk_bf16_f32 %0, %1, %2" : "=v"(r) : "v"(lo), "v"(hi)); return r; }
typedef unsigned u32x2 __attribute__((ext_vector_type(2)));
constexpr float MK_EPS = 1e-6f;
template <int MAXIT, class Sched> __device__ __forceinline__ void rs_table_fill(PG8_LAS float* rst, const float* rowsq, const Sched& S, int tid) {
    f32x4 v[MAXIT][4]; bool ok[MAXIT];
#pragma unroll
    for (int it = 0; it < MAXIT; ++it) { const int idx = tid + it * 512; Unit u; ok[it] = S.next(idx >> 8, u);
        const f32x4* p = (const f32x4*)(rowsq + (size_t)((ok[it] ? u.pm : 0) * BM + (idx & 255)) * 16);
        v[it][0] = p[0]; v[it][1] = p[1]; v[it][2] = p[2]; v[it][3] = p[3]; }
#pragma unroll
    for (int it = 0; it < MAXIT; ++it) { const f32x4 t = (v[it][0] + v[it][1]) + (v[it][2] + v[it][3]);
        if (ok[it]) rst[tid + it * 512] = __builtin_amdgcn_rsqf(((t[0] + t[1]) + (t[2] + t[3])) * (1.0f / 1024.0f) + MK_EPS); }
}
struct EpiProj {
    static constexpr bool PERM = true, AFTER_DRAIN = false;
    PG8_LAS float* rst; const float* rowsq; bf16_t *Q, *K, *V, *G4, *GLR; const float* qg; const float* kg; float c2;
    template <class Sched> __device__ __forceinline__ void prologue(const Sched& S, int tid) const { rs_table_fill<3>(rst, rowsq, S, tid); }
    __device__ __forceinline__ void operator()(const f32x4 (&acc)[2][2][4][2], const Unit& u, int wr, int wc, int fr, int fq) const {
        const int row0 = u.pm * BM + wr * 64 + fr; const int pn = u.pn;
        float rs[2][4]; const PG8_LAS float* rsp = rst + u.ui * BM + wr * 64 + fr;
#pragma unroll
        for (int ai = 0; ai < 2; ++ai)
#pragma unroll
            for (int m = 0; m < 4; ++m) rs[ai][m] = rsp[ai * HALF + m * 16];
        if (pn < 4) {
            const int g = pn * 4 + wc; const bool isq = g < 8; const float* gain = isq ? qg : kg; const float sc = isq ? c2 : 1.0f;
            bf16_t* dst = (isq ? Q : K) + (g & 7) * 64 + 8 * fq;
            f32x4 gv[2][2];
#pragma unroll
            for (int bj = 0; bj < 2; ++bj)
#pragma unroll
                for (int n = 0; n < 2; ++n) gv[bj][n] = *(const f32x4*)(gain + 32 * bj + 8 * fq + 4 * n) * sc;
#pragma unroll
            for (int ai = 0; ai < 2; ++ai)
#pragma unroll
                for (int m = 0; m < 4; ++m) {
                    const float r = rs[ai][m]; f32x4 v[2][2]; float ss = 0.f;
#pragma unroll
                    for (int bj = 0; bj < 2; ++bj)
#pragma unroll
                        for (int n = 0; n < 2; ++n) { v[bj][n] = acc[ai][bj][m][n] * r; const f32x4 q = v[bj][n] * v[bj][n]; ss += (q[0] + q[1]) + (q[2] + q[3]); }
                    ss += __shfl_xor(ss, 16); ss += __shfl_xor(ss, 32);
                    const float rn = __builtin_amdgcn_rsqf(ss * (1.0f / 64.0f) + MK_EPS);
                    bf16_t* rowp = dst + (size_t)(row0 + ai * HALF + m * 16) * 512;
#pragma unroll
                    for (int bj = 0; bj < 2; ++bj) { const f32x4 a = v[bj][0] * rn * gv[bj][0], b = v[bj][1] * rn * gv[bj][1];
                        u32x4 w; w.x = cvt_pk_bf16(a[0], a[1]); w.y = cvt_pk_bf16(a[2], a[3]); w.z = cvt_pk_bf16(b[0], b[1]); w.w = cvt_pk_bf16(b[2], b[3]);
                        *(u32x4*)(rowp + 32 * bj) = w; }
                }
        } else if (pn < 10) {
            bf16_t* dst; int pitch;
            if (pn < 6) { dst = V + (pn - 4) * 256; pitch = 512; } else { dst = G4 + (size_t)(pn - 6) * ((size_t)8 << 20); pitch = 256; }
            dst += 64 * wc + 8 * fq;
#pragma unroll
            for (int ai = 0; ai < 2; ++ai)
#pragma unroll
                for (int m = 0; m < 4; ++m) {
                    const float r = rs[ai][m]; bf16_t* rowp = dst + (size_t)(row0 + ai * HALF + m * 16) * pitch;
#pragma unroll
                    for (int bj = 0; bj < 2; ++bj) { const f32x4 a = acc[ai][bj][m][0] * r, b = acc[ai][bj][m][1] * r;
                        u32x4 w; w.x = cvt_pk_bf16(a[0], a[1]); w.y = cvt_pk_bf16(a[2], a[3]); w.z = cvt_pk_bf16(b[0], b[1]); w.w = cvt_pk_bf16(b[2], b[3]);
                        *(u32x4*)(rowp + 32 * bj) = w; }
                }
        } else {
            if (wc == 0 && fq < 2) {
#pragma unroll
                for (int ai = 0; ai < 2; ++ai)
#pragma unroll
                    for (int m = 0; m < 4; ++m) { const float r = rs[ai][m]; const f32x4 a = acc[ai][0][m][0] * r, b = acc[ai][0][m][1] * r;
                        u32x4 w; w.x = cvt_pk_bf16(a[0], a[1]); w.y = cvt_pk_bf16(a[2], a[3]); w.z = cvt_pk_bf16(b[0], b[1]); w.w = cvt_pk_bf16(b[2], b[3]);
                        *(u32x4*)(GLR + (size_t)(row0 + ai * HALF + m * 16) * 16 + 8 * fq) = w; }
            }
        }
    }
};
template <bool FINAL> struct EpiRes {
    static constexpr bool PERM = false, AFTER_DRAIN = false;
    float* out; bf16_t* HB; float* rowsq_out;
    template <class Sched> __device__ __forceinline__ void prologue(const Sched&, int) const {}
    __device__ __forceinline__ void operator()(const f32x4 (&acc)[2][2][4][2], const Unit& u, int wr, int wc, int fr, int fq) const {
        const int row0 = u.pm * BM + wr * 64 + fr, col0 = u.pn * BM + wc * 32 + 4 * fq;
        u32x2 rr[2][4][2][2];
#pragma unroll
        for (int ai = 0; ai < 2; ++ai)
#pragma unroll
            for (int m = 0; m < 4; ++m) { const size_t off = (size_t)(row0 + ai * HALF + m * 16) * 1024 + col0;
#pragma unroll
                for (int bj = 0; bj < 2; ++bj)
#pragma unroll
                    for (int n = 0; n < 2; ++n) rr[ai][m][bj][n] = *(const u32x2*)(HB + off + bj * HALF + n * 16); }
#pragma unroll
        for (int ai = 0; ai < 2; ++ai)
#pragma unroll
            for (int m = 0; m < 4; ++m) {
                const int row = row0 + ai * HALF + m * 16; const size_t off = (size_t)row * 1024 + col0; float ss = 0.f;
#pragma unroll
                for (int bj = 0; bj < 2; ++bj)
#pragma unroll
                    for (int n = 0; n < 2; ++n) { const u32x2 w0 = rr[ai][m][bj][n];
                        const f32x4 res = {__builtin_bit_cast(float, w0.x << 16), __builtin_bit_cast(float, w0.x & 0xffff0000u), __builtin_bit_cast(float, w0.y << 16), __builtin_bit_cast(float, w0.y & 0xffff0000u)};
                        const f32x4 h = res + acc[ai][bj][m][n];
                        if (FINAL) __builtin_nontemporal_store(h, (f32x4*)(out + off + bj * HALF + n * 16));
                        else { const f32x4 q = h * h; ss += (q[0] + q[1]) + (q[2] + q[3]);
                            u32x2 w; w.x = cvt_pk_bf16(h[0], h[1]); w.y = cvt_pk_bf16(h[2], h[3]); *(u32x2*)(HB + off + bj * HALF + n * 16) = w; } }
                if (!FINAL) { ss += __shfl_xor(ss, 16); ss += __shfl_xor(ss, 32); if (fq == 0) rowsq_out[(size_t)row * 16 + u.pn * 4 + wc] = ss; }
            }
    }
};
struct EpiGU {
    static constexpr bool PERM = true, AFTER_DRAIN = false;
    PG8_LAS float* rst; const float* rowsq; bf16_t* FF;
    template <class Sched> __device__ __forceinline__ void prologue(const Sched& S, int tid) const { rs_table_fill<6>(rst, rowsq, S, tid); }
    __device__ __forceinline__ void operator()(const f32x4 (&acc)[2][2][4][2], const Unit& u, int wr, int wc, int fr, int fq) const {
        const int row0 = u.pm * BM + wr * 64 + fr, col0 = u.pn * 128 + wc * 32 + 8 * fq;
        float rs[2][4]; const PG8_LAS float* rsp = rst + u.ui * BM + wr * 64 + fr;
#pragma unroll
        for (int ai = 0; ai < 2; ++ai)
#pragma unroll
            for (int m = 0; m < 4; ++m) rs[ai][m] = rsp[ai * HALF + m * 16];
#pragma unroll
        for (int ai = 0; ai < 2; ++ai)
#pragma unroll
            for (int m = 0; m < 4; ++m) {
                const int row = row0 + ai * HALF + m * 16; const float r = rs[ai][m];
                const float rneg = r * -1.4426950408889634f, ir2 = __builtin_amdgcn_rcpf(r * r);
                f32x4 f[2];
#pragma unroll
                for (int n = 0; n < 2; ++n) { const f32x4 G = acc[ai][0][m][n], U = acc[ai][1][m][n]; const f32x4 a = G * rneg;
                    const f32x4 e = {__builtin_amdgcn_exp2f(a[0]), __builtin_amdgcn_exp2f(a[1]), __builtin_amdgcn_exp2f(a[2]), __builtin_amdgcn_exp2f(a[3])};
                    const f32x4 d = e * ir2 + ir2;
                    const f32x4 rc = {__builtin_amdgcn_rcpf(d[0]), __builtin_amdgcn_rcpf(d[1]), __builtin_amdgcn_rcpf(d[2]), __builtin_amdgcn_rcpf(d[3])};
                    f[n] = (G * U) * rc; }
                u32x4 w; w.x = cvt_pk_bf16(f[0][0], f[0][1]); w.y = cvt_pk_bf16(f[0][2], f[0][3]); w.z = cvt_pk_bf16(f[1][0], f[1][1]); w.w = cvt_pk_bf16(f[1][2], f[1][3]);
                *(u32x4*)(FF + (size_t)row * 2816 + col0) = w;
            }
    }
};

template <class Epi, class Sched, bool ALIGN_EPI = false, bool SP2 = false>
__device__ __forceinline__ void gemm_phase(PG8_LAS unsigned char* lds, const Gemm g, const Sched& S, const Epi& E) {
    int tid_l = threadIdx.x; asm volatile("" : "+v"(tid_l)); const int tid = tid_l, wid = __builtin_amdgcn_readfirstlane(tid >> 6), lane = tid & 63, wr = wid >> 2, wc = wid & 3, fr = lane & 15, fq = lane >> 4;
    const int K = g.K, nt = K / BK;
    unsigned voffA[2], voffB[2];
#pragma unroll
    for (int i = 0; i < 2; ++i) { int R, C; stage_rc(tid * 16 + i * 8192, R, C); const int Rb = Epi::PERM ? ((R & ~31) + perm32(R & 31)) : R;
        voffA[i] = (unsigned)(R * K + C) * 2u; voffB[i] = (unsigned)(Rb * K + C) * 2u; }
    const size_t kstep = (size_t)(BK * 2);
    const size_t hstep = (size_t)HALF * K * 2;
    const size_t tstep = 2 * hstep;
    const unsigned ldsw = (unsigned)wid * 1024u;
    const int aoff = lds_byte(wr * 64 + fr, fq * 8), boff = lds_byte(wc * 32 + fr, fq * 8);
#define PG8_SA(b, h) (((b) * 2 + (h)) * HTB)
#define PG8_SB(b, h) ((4 + (b) * 2 + (h)) * HTB)
#define PG8_STAGE(bufoff, gbase, voff) do { _Pragma("unroll") for (int _i = 0; _i < 2; ++_i) \
        __builtin_amdgcn_global_load_lds((const unsigned*)((const char*)(gbase) + (voff)[_i]), (PG8_LAS unsigned*)(lds + (bufoff) + ldsw + _i * 8192), 16, 0, 0); } while (0)
#define PG8_LDA(dst, b, h) do { _Pragma("unroll") for (int m = 0; m < 4; ++m) _Pragma("unroll") for (int k = 0; k < 2; ++k) dst[m][k] = *(const PG8_LAS bf16x8*)(lds + PG8_SA(b, h) + aoff + m * 2048 + k * 1024); } while (0)
#define PG8_LDB(dst, b, h) do { _Pragma("unroll") for (int n = 0; n < 2; ++n) _Pragma("unroll") for (int k = 0; k < 2; ++k) dst[n][k] = *(const PG8_LAS bf16x8*)(lds + PG8_SB(b, h) + boff + n * 2048 + k * 1024); } while (0)
#define PG8_MMA(ai, bj, At, Bt) do { __builtin_amdgcn_s_setprio(1); asm volatile(MK_ALIGN_MMA); _Pragma("unroll") for (int m = 0; m < 4; ++m) _Pragma("unroll") for (int n = 0; n < 2; ++n) _Pragma("unroll") for (int k = 0; k < 2; ++k) \
        acc[ai][bj][m][n] = __builtin_amdgcn_mfma_f32_16x16x32_bf16(Bt[n][k], At[m][k], acc[ai][bj][m][n], 0, 0, 0); __builtin_amdgcn_s_setprio(0); } while (0)
#define PG8_WAIT_V(n) do { asm volatile("" ::: "memory"); __builtin_amdgcn_s_waitcnt((((n) & 15) | (((n) >> 4) << 14)) | 0x0F70); asm volatile("" ::: "memory"); } while (0)
#define PG8_WAIT_L(n) do { asm volatile("" ::: "memory"); __builtin_amdgcn_s_waitcnt(0xC07F | ((n) << 8)); asm volatile("" ::: "memory"); } while (0)
#define PG8_BAR __builtin_amdgcn_s_barrier()
#define PG8_SCHED __builtin_amdgcn_sched_barrier(0)
    Unit cur, nxt; int ui = 0;
    if (!S.next(0, cur)) return;
    f32x4 acc[2][2][4][2];
#pragma unroll
    for (int a = 0; a < 2; ++a)
#pragma unroll
        for (int b = 0; b < 2; ++b)
#pragma unroll
            for (int m = 0; m < 4; ++m)
#pragma unroll
                for (int n = 0; n < 2; ++n) acc[a][b][m][n] = (f32x4){0.f, 0.f, 0.f, 0.f};
    bf16x8 At[4][2], B0[2][2], B1[2][2];
    const char* cA = (const char*)g.A + (size_t)cur.pm * tstep; const char* cB = (const char*)g.Bt + (size_t)cur.pn * tstep;
    S.a_ready(cur);
    if constexpr (SP2) {
        PG8_STAGE(PG8_SB(0, 0), cB, voffB); PG8_STAGE(PG8_SB(0, 1), cB + hstep, voffB); PG8_STAGE(PG8_SA(0, 0), cA, voffA); PG8_STAGE(PG8_SA(0, 1), cA + hstep, voffA);
        E.prologue(S, tid);
        if (wr == 1) PG8_BAR;
        PG8_WAIT_V(2); PG8_BAR;
        PG8_STAGE(PG8_SB(1, 0), cB + kstep, voffB); PG8_STAGE(PG8_SA(1, 0), cA + kstep, voffA); PG8_STAGE(PG8_SB(1, 1), cB + hstep + kstep, voffB);
        PG8_WAIT_V(6); PG8_BAR;
    } else {
        PG8_STAGE(PG8_SB(0, 0), cB, voffB); PG8_STAGE(PG8_SA(0, 0), cA, voffA); PG8_STAGE(PG8_SB(0, 1), cB + hstep, voffB); PG8_STAGE(PG8_SA(0, 1), cA + hstep, voffA);
        if (wr == 1) PG8_BAR;
        PG8_WAIT_V(4); PG8_BAR;
        PG8_STAGE(PG8_SB(1, 0), cB + kstep, voffB); PG8_STAGE(PG8_SA(1, 0), cA + kstep, voffA); PG8_STAGE(PG8_SB(1, 1), cB + hstep + kstep, voffB);
        PG8_WAIT_V(6); PG8_BAR;
    }
    for (;;) {
        const bool has_next = S.next(ui + 1, nxt);
        const char* nA = has_next ? (const char*)g.A + (size_t)nxt.pm * tstep : cA; const char* nB = has_next ? (const char*)g.Bt + (size_t)nxt.pn * tstep : cB;
        asm volatile(MK_ALIGN_GEMM);
        for (int t = 0; t < nt; t += 2) {
            const bool last = (t == nt - 2);
            const char* a1 = cA + (size_t)(t + 1) * kstep;
            const char* a2 = last ? nA : cA + (size_t)(t + 2) * kstep; const char* b2 = last ? nB : cB + (size_t)(t + 2) * kstep;
            const char* a3 = a2 + kstep; const char* b3 = b2 + kstep;
            if (last && has_next) S.a_ready(nxt);
            if constexpr (SP2) {
            PG8_LDB(B0, 0, 0); PG8_LDB(B1, 0, 1); PG8_SCHED; PG8_LDA(At, 0, 0); PG8_STAGE(PG8_SA(1, 1), a1 + hstep, voffA);
            PG8_WAIT_V(8); PG8_WAIT_L(0); PG8_BAR; PG8_MMA(0, 0, At, B0); PG8_MMA(0, 1, At, B1); PG8_BAR; PG8_SCHED;
            PG8_LDA(At, 0, 1); PG8_STAGE(PG8_SB(0, 0), b2, voffB); PG8_STAGE(PG8_SB(0, 1), b2 + hstep, voffB); PG8_STAGE(PG8_SA(0, 0), a2, voffA);
            PG8_WAIT_V(8); PG8_WAIT_L(0); PG8_BAR; PG8_MMA(1, 0, At, B0); PG8_MMA(1, 1, At, B1); PG8_BAR; PG8_SCHED;
            PG8_LDB(B0, 1, 0); PG8_LDB(B1, 1, 1); PG8_SCHED; PG8_LDA(At, 1, 0); PG8_STAGE(PG8_SA(0, 1), a2 + hstep, voffA);
            PG8_WAIT_V(8); PG8_WAIT_L(0); PG8_BAR; PG8_MMA(0, 0, At, B0); PG8_MMA(0, 1, At, B1); PG8_BAR; PG8_SCHED;
            PG8_LDA(At, 1, 1); PG8_STAGE(PG8_SB(1, 0), b3, voffB); PG8_STAGE(PG8_SB(1, 1), b3 + hstep, voffB); PG8_STAGE(PG8_SA(1, 0), a3, voffA);
            PG8_WAIT_V(8); PG8_WAIT_L(0); PG8_BAR; PG8_MMA(1, 0, At, B0); PG8_MMA(1, 1, At, B1); PG8_BAR; PG8_SCHED;
            } else {
            PG8_LDB(B0, 0, 0); PG8_SCHED; PG8_LDA(At, 0, 0); PG8_STAGE(PG8_SA(1, 1), a1 + hstep, voffA);
            PG8_WAIT_L(8); PG8_BAR; PG8_WAIT_L(0); PG8_MMA(0, 0, At, B0); PG8_BAR; PG8_SCHED;
            PG8_LDB(B1, 0, 1); PG8_STAGE(PG8_SB(0, 0), b2, voffB);
            PG8_BAR; PG8_WAIT_L(0); PG8_MMA(0, 1, At, B1); PG8_BAR;
            PG8_LDA(At, 0, 1); PG8_STAGE(PG8_SA(0, 0), a2, voffA);
            PG8_BAR; PG8_WAIT_L(0); PG8_MMA(1, 0, At, B0); PG8_BAR; PG8_SCHED;
            PG8_STAGE(PG8_SB(0, 1), b2 + hstep, voffB);
            PG8_WAIT_V(6); PG8_BAR; PG8_MMA(1, 1, At, B1); PG8_BAR;
            PG8_LDB(B0, 1, 0); PG8_SCHED; PG8_LDA(At, 1, 0); PG8_STAGE(PG8_SA(0, 1), a2 + hstep, voffA);
            PG8_WAIT_L(8); PG8_BAR; PG8_WAIT_L(0); PG8_MMA(0, 0, At, B0); PG8_BAR; PG8_SCHED;
            PG8_LDB(B1, 1, 1); PG8_STAGE(PG8_SB(1, 0), b3, voffB);
            PG8_BAR; PG8_WAIT_L(0); PG8_MMA(0, 1, At, B1); PG8_BAR;
            PG8_LDA(At, 1, 1); PG8_STAGE(PG8_SA(1, 0), a3, voffA);
            PG8_BAR; PG8_WAIT_L(0); PG8_MMA(1, 0, At, B0); PG8_BAR; PG8_SCHED;
            PG8_STAGE(PG8_SB(1, 1), b3 + hstep, voffB);
            PG8_WAIT_V(6); PG8_BAR; PG8_MMA(1, 1, At, B1); PG8_BAR;
            }
        }
        if constexpr (ALIGN_EPI) { if (wr == 0) PG8_BAR; }
        if constexpr (!Epi::AFTER_DRAIN) { E(acc, cur, wr, wc, fr, fq); S.done(cur); }
        if (!has_next) break;
#pragma unroll
        for (int a = 0; a < 2; ++a)
#pragma unroll
            for (int b = 0; b < 2; ++b)
#pragma unroll
                for (int m = 0; m < 4; ++m)
#pragma unroll
                    for (int n = 0; n < 2; ++n) acc[a][b][m][n] = (f32x4){0.f, 0.f, 0.f, 0.f};
        cur = nxt; cA = nA; cB = nB; ++ui;
        if constexpr (ALIGN_EPI) { if (wr == 1) PG8_BAR; }
    }
    PG8_WAIT_V(0);
    if constexpr (!ALIGN_EPI) { if (wr == 0) PG8_BAR; }
    PG8_BAR;
    if constexpr (Epi::AFTER_DRAIN) { E.fused(acc, cur, wr, wc, fr, fq, lds, wid, lane); S.done(cur); }
#undef PG8_SA
#undef PG8_SB
#undef PG8_STAGE
#undef PG8_LDA
#undef PG8_LDB
#undef PG8_MMA
#undef PG8_WAIT_V
#undef PG8_WAIT_L
#undef PG8_BAR
#undef PG8_SCHED
}
}
#include <hip/hip_bf16.h>
namespace attn_body {
using bf16=__hip_bfloat16;
using bf16x8=__attribute__((ext_vector_type(8)))short;
using s16x4=__attribute__((ext_vector_type(4)))short;
using f32x16=__attribute__((ext_vector_type(16)))float;
using u32x4=__attribute__((ext_vector_type(4)))unsigned;
constexpr int BATCH=16,SEQ=2048,D=64,QP=512,KP=512,VP=512,OP=1024;
constexpr int NW=8,QBLK=32,QB=QBLK*NW,KVBLK=64,NQB=SEQ/QB;
constexpr int ATTN_UNIT_ROWS=QB;
__device__ __forceinline__ int crow(int r,int hi){return (r&3)+8*(r>>2)+4*hi;}
#define SBAR() __builtin_amdgcn_sched_barrier(0)
__device__ __forceinline__ void cmask(f32x16&p0,f32x16&p1,int jb,int qrel,int hi){
  const float NEG=-INFINITY; int kb=64*jb+4*hi;
  #pragma unroll
  for(int r=0;r<16;++r){int kv=kb+(r&3)+8*(r>>2); if(kv>qrel)p0[r]=NEG; if(kv+32>qrel)p1[r]=NEG;}
}

__device__ __forceinline__ void bmask(f32x16&p0,f32x16&p1,int jb6,int qrel,int hi,const __attribute__((address_space(3))) float*rt){
  const __attribute__((address_space(3))) float*p=rt+(255-qrel+64*jb6+4*hi);
  #pragma unroll
  for(int r=0;r<16;++r){const int o=(r&3)+8*(r>>2); p0[r]+=p[o]; p1[r]+=p[o+32];}
}
constexpr int NSLOT=3, SLOTB=8192;
constexpr int LDS_K=0, LDS_V=NSLOT*SLOTB, LDS_WS=2*NSLOT*SLOTB, LDS_OST=LDS_WS+NW*64*4, LDS_BYTES=LDS_OST+NW*4096;
constexpr float C2=0.125f*1.4426950408889634f;
__device__ __forceinline__ void glds16(const void*gsrc,unsigned lds_dst){unsigned keep;
  asm volatile("s_mov_b32 %0, m0\n\ts_mov_b32 m0, %2\n\ts_nop 0\n\tglobal_load_lds_dwordx4 %1, off\n\ts_mov_b32 m0, %0":"=&s"(keep):"v"(gsrc),"s"(lds_dst):"memory");}
__device__ __forceinline__ float max3f(float a,float b,float c){float r;asm("v_max3_f32 %0, %1, %2, %3":"=v"(r):"v"(a),"v"(b),"v"(c));return r;}
__device__ __forceinline__ float max2f(float a,float b){float r;asm("v_max_f32_e32 %0, %1, %2":"=v"(r):"v"(a),"v"(b));return r;}
__device__ __forceinline__ float fadd_s(float a,float b){float r;asm("v_add_f32_e32 %0, %1, %2":"=v"(r):"v"(a),"v"(b));return r;}
__device__ __forceinline__ float fsub_s(float a,float b){float r;asm("v_sub_f32_e32 %0, %1, %2":"=v"(r):"v"(a),"v"(b));return r;}
typedef float f32x2_t __attribute__((ext_vector_type(2))); typedef __bf16 bf16x2_t __attribute__((ext_vector_type(2)));
__device__ __forceinline__ unsigned cvtpk_s(float lo,float hi){f32x2_t v={lo,hi};bf16x2_t b=__builtin_convertvector(v,bf16x2_t);return __builtin_bit_cast(unsigned,b);}
#define WAIT_BAR(N) asm volatile("s_waitcnt vmcnt(" #N ") lgkmcnt(0)\n\ts_barrier":::"memory")

__device__ __forceinline__ void qkt(f32x16&p0,f32x16&p1,const char*Kslot,const bf16x8*qr,const f32x16&negm,int r32,int hi){
  const char*kb=Kslot+hi*1024+r32*16;
  #pragma unroll
  for(int d0=0;d0<4;++d0){
    const bf16x8 b0=*reinterpret_cast<const bf16x8*>(kb+d0*2048);
    const bf16x8 b1=*reinterpret_cast<const bf16x8*>(kb+d0*2048+512);
    if(d0==0){p0=__builtin_amdgcn_mfma_f32_32x32x16_bf16(b0,qr[0],negm,0,0,0);p1=__builtin_amdgcn_mfma_f32_32x32x16_bf16(b1,qr[0],negm,0,0,0);}
    else{p0=__builtin_amdgcn_mfma_f32_32x32x16_bf16(b0,qr[d0],p0,0,0,0);p1=__builtin_amdgcn_mfma_f32_32x32x16_bf16(b1,qr[d0],p1,0,0,0);}}
}
typedef __attribute__((address_space(3))) const char* lds_cptr;
typedef short v4i16_t __attribute__((ext_vector_type(4)));
__device__ __forceinline__ void kload8(bf16x8*kf,lds_cptr kp){
  kf[0]=*(const __attribute__((address_space(3))) bf16x8*)(kp);      kf[1]=*(const __attribute__((address_space(3))) bf16x8*)(kp+512);
  kf[2]=*(const __attribute__((address_space(3))) bf16x8*)(kp+2048); kf[3]=*(const __attribute__((address_space(3))) bf16x8*)(kp+2560);
  kf[4]=*(const __attribute__((address_space(3))) bf16x8*)(kp+4096); kf[5]=*(const __attribute__((address_space(3))) bf16x8*)(kp+4608);
  kf[6]=*(const __attribute__((address_space(3))) bf16x8*)(kp+6144); kf[7]=*(const __attribute__((address_space(3))) bf16x8*)(kp+6656);
}
__device__ __forceinline__ void kload2(bf16x8*kf,lds_cptr kp,int j){ kf[2*j]=*(const __attribute__((address_space(3))) bf16x8*)(kp+j*2048); kf[2*j+1]=*(const __attribute__((address_space(3))) bf16x8*)(kp+j*2048+512); }
__device__ __forceinline__ s16x4 vtr(lds_cptr p){ return __builtin_bit_cast(s16x4,__builtin_amdgcn_ds_read_tr16_b64_v4i16((__attribute__((address_space(3))) v4i16_t*)p)); }
__device__ __forceinline__ float rowmax(const f32x16&p0,const f32x16&p1){
  float a=max3f(p0[0],p0[1],p1[0]),b=max3f(p0[2],p0[3],p1[1]);a=max3f(a,p1[2],p1[3]);
  #pragma unroll
  for(int r=4;r<16;r+=4){a=max3f(a,p0[r],p0[r+1]);b=max3f(b,p0[r+2],p0[r+3]);a=max3f(a,p1[r],p1[r+1]);b=max3f(b,p1[r+2],p1[r+3]);}
  const float m=max2f(a,b);
  auto rr=__builtin_amdgcn_permlane32_swap(__float_as_uint(m),__float_as_uint(m),false,false);
  return max2f(__uint_as_float(rr[0]),__uint_as_float(rr[1]));
}
__device__ __forceinline__ void pv(f32x16*o,int vb,bf16x8 pa0,bf16x8 pa1,bf16x8 pa2,bf16x8 pa3){
  #pragma unroll
  for(int d0=0;d0<2;++d0){s16x4 lo[4],hi[4];
    #pragma unroll
    for(int ks=0;ks<4;++ks){
      asm volatile("ds_read_b64_tr_b16 %0,%1 offset:%c2":"=&v"(lo[ks]):"v"(vb),"i"(d0*4096+ks*1024):"memory");
      asm volatile("ds_read_b64_tr_b16 %0,%1 offset:%c2":"=&v"(hi[ks]):"v"(vb),"i"(d0*4096+ks*1024+512):"memory");}
    asm volatile("s_waitcnt lgkmcnt(0)":::"memory");SBAR();
    #define PK(k) (bf16x8){lo[k][0],lo[k][1],lo[k][2],lo[k][3],hi[k][0],hi[k][1],hi[k][2],hi[k][3]}
    o[d0]=__builtin_amdgcn_mfma_f32_32x32x16_bf16(pa0,PK(0),o[d0],0,0,0);
    o[d0]=__builtin_amdgcn_mfma_f32_32x32x16_bf16(pa1,PK(1),o[d0],0,0,0);
    o[d0]=__builtin_amdgcn_mfma_f32_32x32x16_bf16(pa2,PK(2),o[d0],0,0,0);
    o[d0]=__builtin_amdgcn_mfma_f32_32x32x16_bf16(pa3,PK(3),o[d0],0,0,0);
    #undef PK
  }
}

#ifndef ATTN_STORE16
#define ATTN_STORE16(p,v) (*(u32x4*)(p)=(v))
#endif
template<int THRL> __device__ __forceinline__ void attn_unit(int b,int qb,const bf16*Q,const bf16*__restrict__ K,const bf16*__restrict__ V,bf16*O,char*shm,const __attribute__((address_space(3))) float*rt){
  int tid_l=threadIdx.x; asm volatile("":"+v"(tid_l)); const int tid=tid_l,lane=tid&63,r32=lane&31,hi=lane>>5; const int wid=__builtin_amdgcn_readfirstlane(tid>>6);
  const long rowbase=(long)b*SEQ; const int q0=qb*QB;
  const bf16*Qw=Q+(rowbase+q0+wid*QBLK)*QP;
  const bf16*Kh=K+rowbase*KP,*Vh=V+rowbase*VP;
  const unsigned lds0=(unsigned)(uintptr_t)shm;
  float*wsf=(float*)(shm+LDS_WS)+wid*64;
  const bf16*ksrc=Kh+(long)lane*KP+wid*8;
  const bf16*vsrc=Vh+(long)(16*(wid&3)+(lane>>2))*VP+(wid>>2)*32+(lane&3)*8;
  const unsigned kdst=lds0+LDS_K+wid*1024, vdst=lds0+LDS_V+wid*1024;
  #define DMA_K(t,slot) glds16(ksrc+(long)(t)*KVBLK*KP,(unsigned)__builtin_amdgcn_readfirstlane(kdst+(slot)))
  #define DMA_V(t,slot) glds16(vsrc+(long)(t)*KVBLK*VP,(unsigned)__builtin_amdgcn_readfirstlane(vdst+(slot)))
  const int vb0=(int)(lds0+LDS_V)+((lane>>4)&1)*32+(lane&3)*8+(4*hi+((lane&15)>>2))*64;
  const char*Kbase=shm+LDS_K; bf16x8 kf[8];
  const lds_cptr shm3=(lds_cptr)shm; const lds_cptr kp0=shm3+LDS_K+hi*1024+r32*16; const lds_cptr vp0=shm3+LDS_V+((lane>>4)&1)*32+(lane&3)*8+(4*hi+((lane&15)>>2))*64;
  const int NT=(q0+QB)/KVBLK;
  DMA_K(0,0);DMA_V(0,0);DMA_K(1,SLOTB);
  bf16x8 qr[4];
  #pragma unroll
  for(int d0=0;d0<4;++d0)qr[d0]=*reinterpret_cast<const bf16x8*>(&Qw[(long)r32*QP+d0*16+hi*8]);
  float mhat=0.f,l_reg=0.f;f32x16 o[2];o[0]=f32x16{};o[1]=f32x16{};f32x16 negm=f32x16{};asm volatile("":"+v"(negm));
  const int qrel=wid*QBLK+r32;
  #define CMASK(P0,P1,t) do{int jb_=(t)-(NT-6); if(jb_>=0)bmask(P0,P1,jb_,qrel,hi,rt);}while(0)
  bool resc=false;
  #define START(P0,P1) do{ const float rm=rowmax(P0,P1); resc=false; \
    { const float dl=rm; mhat=fadd_s(mhat,dl); \
      _Pragma("unroll") for(int r=0;r<16;++r){P0[r]=fsub_s(P0[r],dl);P1[r]=fsub_s(P1[r],dl);} \
      _Pragma("unroll") for(int r=0;r<16;++r)negm[r]=-mhat; asm volatile("":"+v"(negm)); } \
    _Pragma("unroll") for(int r=0;r<16;++r)P0[r]=__builtin_amdgcn_exp2f(P0[r]); }while(0)
  #define RESC() do{ if(resc){ asm volatile("s_waitcnt lgkmcnt(0)":::"memory"); \
      _Pragma("unroll") for(int d_=0;d_<2;++d_) _Pragma("unroll") for(int r=0;r<16;++r)o[d_][r]*=wsf[crow(r,hi)]; } }while(0)
  f32x16 pA0,pA1,pB0,pB1;
  int sl_prev=0,sl_cur=0,sl_next=SLOTB;
  #define ROT() do{sl_prev=sl_cur;sl_cur=sl_next;sl_next=(sl_next==(NSLOT-1)*SLOTB)?0:sl_next+SLOTB;}while(0)
  DMA_K(2,2*SLOTB);
  WAIT_BAR(3);
  qkt(pA0,pA1,Kbase,qr,negm,r32,hi);asm volatile("s_nop 15\n\ts_nop 7":"+v"(pA0),"+v"(pA1));CMASK(pA0,pA1,0);
  START(pA0,pA1);
  _Pragma("unroll") for(int r=0;r<16;++r)pA1[r]=__builtin_amdgcn_exp2f(pA1[r]);
  WAIT_BAR(0);
  DMA_K(3,0);DMA_V(1,SLOTB);
  ROT();
  kload8(kf,kp0+sl_cur);
  WAIT_BAR(2);
  s16x4 vlo[8],vhi[8]; u32x4 pw0,pw1,pw2,pw3;
  #define PKW(P,B) cvtpk_s(P[B],P[B+1])
  #define PAF(k) __builtin_bit_cast(bf16x8,pw##k)
  #define VFR(i) (bf16x8){vlo[i][0],vlo[i][1],vlo[i][2],vlo[i][3],vhi[i][0],vhi[i][1],vhi[i][2],vhi[i][3]}
  #define PIN(x) asm volatile("":"+v"(x))
  #define MX3(a,b,c) __builtin_fmaxf(__builtin_fmaxf((a),(b)),(c))
  #define GAPA(MF,A0,A1,A2,A3,W0,W1,PW) do{ MF; sacc+=A0; sacc+=A1; sacc+=A2; sacc+=A3; PIN(sacc); W0; W1; PIN(PW); SBAR(); }while(0)
  #define EX(v) __builtin_amdgcn_exp2f(v)
  #define GAPB(MF,X,B) do{ MF; X[B]=EX(X[B]); X[B+1]=EX(X[B+1]); X[B+2]=EX(X[B+2]); X[B+3]=EX(X[B+3]); PIN(X); SBAR(); }while(0)
  #define VRD(i) do{ vlo[i]=vtr(vp_+(((i)>>2)*4096+((i)&3)*1024)); vhi[i]=vtr(vp_+(((i)>>2)*4096+((i)&3)*1024+512)); }while(0)
  #define KRD(G,j) do{ if(G){ kload2(kf,kp0+sl_next,j); SBAR(); } }while(0)
  #define STEP(C0,C1,P0,P1,t,GK,GV,GL) do{ SBAR(); \
    const lds_cptr vp_=vp0+sl_prev; \
    VRD(0); SBAR(); float sacc=(P0[0]+P0[1]); \
    GAPA(C0=__builtin_amdgcn_mfma_f32_32x32x16_bf16(kf[0],qr[0],negm,0,0,0), P0[2],P0[3],P0[4],P0[5],     pw0[0]=PKW(P0,0), pw0[1]=PKW(P0,2), pw0); \
    VRD(4); SBAR(); GAPA(C1=__builtin_amdgcn_mfma_f32_32x32x16_bf16(kf[1],qr[0],negm,0,0,0), P0[6],P0[7],P0[8],P0[9],     pw0[2]=PKW(P0,4), pw0[3]=PKW(P0,6), pw0); \
    VRD(1); SBAR(); GAPA(C0=__builtin_amdgcn_mfma_f32_32x32x16_bf16(kf[2],qr[1],C0,0,0,0),   P0[10],P0[11],P0[12],P0[13], pw1[0]=PKW(P0,8), pw1[1]=PKW(P0,10), pw1); \
    VRD(5); SBAR(); GAPA(C1=__builtin_amdgcn_mfma_f32_32x32x16_bf16(kf[3],qr[1],C1,0,0,0),   P0[14],P0[15],P1[0],P1[1],   pw1[2]=PKW(P0,12),pw1[3]=PKW(P0,14), pw1); \
    VRD(2); SBAR(); GAPA(C0=__builtin_amdgcn_mfma_f32_32x32x16_bf16(kf[4],qr[2],C0,0,0,0),   P1[2],P1[3],P1[4],P1[5],     pw2[0]=PKW(P1,0), pw2[1]=PKW(P1,2), pw2); \
    VRD(6); SBAR(); GAPA(C1=__builtin_amdgcn_mfma_f32_32x32x16_bf16(kf[5],qr[2],C1,0,0,0),   P1[6],P1[7],P1[8],P1[9],     pw2[2]=PKW(P1,4), pw2[3]=PKW(P1,6), pw2); \
    VRD(3); SBAR(); GAPA(C0=__builtin_amdgcn_mfma_f32_32x32x16_bf16(kf[6],qr[3],C0,0,0,0),   P1[10],P1[11],P1[12],P1[13], pw3[0]=PKW(P1,8), pw3[1]=PKW(P1,10), pw3); \
    VRD(7); SBAR(); GAPA(C1=__builtin_amdgcn_mfma_f32_32x32x16_bf16(kf[7],qr[3],C1,0,0,0),   P1[14],P1[15],0.f,0.f,       pw3[2]=PKW(P1,12),pw3[3]=PKW(P1,14), pw3); \
    l_reg+=sacc; \
    if(GK){DMA_K((t)+3,sl_cur);} if(GV){DMA_V((t)+1,sl_next);} \
    CMASK(C0,C1,t); \
    { float a=MX3(C0[0],C0[1],C1[0]),b=MX3(C0[2],C0[3],C1[1]); a=MX3(a,C1[2],C1[3]); \
      _Pragma("unroll") for(int r=4;r<16;r+=4){a=MX3(a,C0[r],C0[r+1]);b=MX3(b,C0[r+2],C0[r+3]);a=MX3(a,C1[r],C1[r+1]);b=MX3(b,C1[r+2],C1[r+3]);} \
      float rm=__builtin_fmaxf(a,b); { auto rr=__builtin_amdgcn_permlane32_swap(__float_as_uint(rm),__float_as_uint(rm),false,false); rm=__builtin_fmaxf(__uint_as_float(rr[0]),__uint_as_float(rr[1])); } \
      resc=false; \
      if(__builtin_expect(__any(rm>(float)THRL),0)){ const float dl=__builtin_fmaxf(rm,0.f); mhat+=dl; \
        _Pragma("unroll") for(int r=0;r<16;++r){C0[r]-=dl;C1[r]-=dl;} \
        _Pragma("unroll") for(int r=0;r<16;++r)negm[r]=-mhat; asm volatile("":"+v"(negm)); \
        const float f=__builtin_amdgcn_exp2f(-dl); l_reg*=f; if(hi==0)wsf[r32]=f; resc=true; } } \
    SBAR(); \
    GAPB(o[0]=__builtin_amdgcn_mfma_f32_32x32x16_bf16(PAF(0),VFR(0),o[0],0,0,0), C0,0); \
    GAPB(o[1]=__builtin_amdgcn_mfma_f32_32x32x16_bf16(PAF(0),VFR(4),o[1],0,0,0), C0,4); \
    KRD(GL,0); GAPB(o[0]=__builtin_amdgcn_mfma_f32_32x32x16_bf16(PAF(1),VFR(1),o[0],0,0,0), C0,8); \
    KRD(GL,1); GAPB(o[1]=__builtin_amdgcn_mfma_f32_32x32x16_bf16(PAF(1),VFR(5),o[1],0,0,0), C0,12); \
    KRD(GL,2); GAPB(o[0]=__builtin_amdgcn_mfma_f32_32x32x16_bf16(PAF(2),VFR(2),o[0],0,0,0), C1,0); \
    KRD(GL,3); GAPB(o[1]=__builtin_amdgcn_mfma_f32_32x32x16_bf16(PAF(2),VFR(6),o[1],0,0,0), C1,4); \
    GAPB(o[0]=__builtin_amdgcn_mfma_f32_32x32x16_bf16(PAF(3),VFR(3),o[0],0,0,0), C1,8); \
    GAPB(o[1]=__builtin_amdgcn_mfma_f32_32x32x16_bf16(PAF(3),VFR(7),o[1],0,0,0), C1,12); \
    }while(0)
  int t=1;
  #undef CMASK
  #define CMASK(P0,P1,t) do{}while(0)
  for(;t+7<NT;t+=2){
    STEP(pB0,pB1,pA0,pA1,t,true,true,true);     WAIT_BAR(2); RESC(); ROT();
    STEP(pA0,pA1,pB0,pB1,t+1,true,true,true);   WAIT_BAR(2); RESC(); ROT();
  }
  #undef CMASK
  #define CMASK(P0,P1,t) do{int jb_=(t)-(NT-6); if(jb_>=0)bmask(P0,P1,jb_,qrel,hi,rt);}while(0)
  #define ENDW(tt) do{ if((tt)+3<NT){WAIT_BAR(2);} else if((tt)+2<NT){WAIT_BAR(1);} else {WAIT_BAR(0);} }while(0)
  for(;t+1<NT;t+=2){
    STEP(pB0,pB1,pA0,pA1,t,(t+3<NT),(t+1<NT),(t+1<NT));       ENDW(t);   RESC(); ROT();
    STEP(pA0,pA1,pB0,pB1,t+1,(t+4<NT),(t+2<NT),(t+2<NT));     ENDW(t+1); RESC(); ROT();
  }
  STEP(pB0,pB1,pA0,pA1,NT-1,false,false,false); RESC();
  { float sacc=pB0[0]+pB0[1]; _Pragma("unroll") for(int r=2;r<16;++r)sacc+=pB0[r]; _Pragma("unroll") for(int r=0;r<16;++r)sacc+=pB1[r]; l_reg+=sacc;
    pw0=(u32x4){PKW(pB0,0),PKW(pB0,2),PKW(pB0,4),PKW(pB0,6)};pw1=(u32x4){PKW(pB0,8),PKW(pB0,10),PKW(pB0,12),PKW(pB0,14)};pw2=(u32x4){PKW(pB1,0),PKW(pB1,2),PKW(pB1,4),PKW(pB1,6)};pw3=(u32x4){PKW(pB1,8),PKW(pB1,10),PKW(pB1,12),PKW(pB1,14)};
    SBAR(); pv(o,vb0+sl_cur,PAF(0),PAF(1),PAF(2),PAF(3)); }
  #undef PKW
  #undef PAF
  #undef VFR
  #undef PIN
  #undef MX3
  #undef GAPA
  #undef GAPB
  #undef EX
  #undef VRD
  #undef KRD
  #undef STEP
  #undef ENDW
  {auto rr=__builtin_amdgcn_permlane32_swap(__float_as_uint(l_reg),__float_as_uint(l_reg),false,false);l_reg=__uint_as_float(rr[0])+__uint_as_float(rr[1]);}
  if(hi==0)wsf[32+r32]=l_reg;asm volatile("s_waitcnt lgkmcnt(0)":::"memory");
  float rli[16];
  #pragma unroll
  for(int r=0;r<16;++r)rli[r]=__builtin_amdgcn_rcpf(wsf[32+crow(r,hi)]);
  bf16*Ow=O+(rowbase+q0+wid*QBLK)*OP;
  { bf16*stg=(bf16*)(shm+LDS_OST)+wid*2048;
    #pragma unroll
    for(int r=0;r<16;++r){const int orow=crow(r,hi);
      #pragma unroll
      for(int d0=0;d0<2;++d0)stg[orow*64+d0*32+r32]=__float2bfloat16(o[d0][r]*rli[r]);}
    asm volatile("s_waitcnt lgkmcnt(0)":::"memory");
    #pragma unroll
    for(int i=0;i<4;++i){const int row=i*8+(lane>>3),ch=lane&7; const u32x4 v=*(const u32x4*)(stg+row*64+ch*8); ATTN_STORE16(Ow+(long)row*OP+ch*8,v);} }
  asm volatile("s_waitcnt lgkmcnt(0)\n\ts_barrier":::"memory");
  #undef DMA_K
  #undef DMA_V
  #undef CMASK
  #undef START
  #undef RESC
  #undef ROT
}
constexpr int VSLOTB=16384;
constexpr int L2_K=0, L2_V=NSLOT*SLOTB, L2_WS=L2_V+NSLOT*VSLOTB, L2_BYTES=L2_WS+NW*64*4;
__device__ __forceinline__ float att_sum16(float x) {
    x += __int_as_float(__builtin_amdgcn_update_dpp(0, __float_as_int(x), 0xB1, 0xf, 0xf, true));
    x += __int_as_float(__builtin_amdgcn_update_dpp(0, __float_as_int(x), 0x4E, 0xf, 0xf, true));
    x += __int_as_float(__builtin_amdgcn_update_dpp(0, __float_as_int(x), 0x141, 0xf, 0xf, true));
    x += __int_as_float(__builtin_amdgcn_update_dpp(0, __float_as_int(x), 0x140, 0xf, 0xf, true));
    return x;
}
template<int POST> __device__ __forceinline__ void attn_unit2(int b,int qb,const bf16*Q,const bf16*__restrict__ K,const bf16*__restrict__ V,bf16*O,char*shm,const __attribute__((address_space(3))) float*rt,
                                                              const bf16*O0=nullptr,bf16*MIXo=nullptr,float lam=0.f,float osc=0.f,const float*subg=nullptr){
  int tid_l=threadIdx.x; asm volatile("":"+v"(tid_l)); const int tid=tid_l,lane=tid&63,r32=lane&31,hi=lane>>5; const int wid=__builtin_amdgcn_readfirstlane(tid>>6);
  const long rowbase=(long)b*SEQ; const int q0=qb*QB;
  const bf16*Qw=Q+(rowbase+q0+wid*QBLK)*QP;
  const bf16*Kh=K+rowbase*KP,*Vh=V+rowbase*VP;
  const unsigned lds0=(unsigned)(uintptr_t)shm;
  float*wsf=(float*)(shm+L2_WS)+wid*64;
  const bf16*ksrc=Kh+(long)lane*KP+wid*8;
  const bf16*vsrc=Vh+(long)(16*(wid&3)+(lane>>2))*VP+(wid>>2)*32+(lane&3)*8;
  const unsigned kdst=lds0+L2_K+wid*1024, vdst=lds0+L2_V+wid*1024;
  #define DMA_K(t,slot) glds16(ksrc+(long)(t)*KVBLK*KP,(unsigned)__builtin_amdgcn_readfirstlane(kdst+(slot)))
  #define DMA_V(t,slot) do{ glds16(vsrc+(long)(t)*KVBLK*VP,(unsigned)__builtin_amdgcn_readfirstlane(vdst+(slot))); glds16(vsrc+(long)(t)*KVBLK*VP+64,(unsigned)__builtin_amdgcn_readfirstlane(vdst+(slot)+8192)); }while(0)
  const char*Kbase=shm+L2_K; bf16x8 kf[8];
  const lds_cptr shm3=(lds_cptr)shm; const lds_cptr kp0=shm3+L2_K+hi*1024+r32*16; const lds_cptr vp0=shm3+L2_V+((lane>>4)&1)*32+(lane&3)*8+(4*hi+((lane&15)>>2))*64;
  const int NT=(q0+QB)/KVBLK;
  bf16x8 qr[4];
  #pragma unroll
  for(int d0=0;d0<4;++d0)qr[d0]=*reinterpret_cast<const bf16x8*>(&Qw[(long)r32*QP+d0*16+hi*8]);
  DMA_K(0,0);DMA_K(1,SLOTB);DMA_V(0,0);DMA_K(2,2*SLOTB);
  float l_reg=0.f; f32x16 o[4]; o[0]=f32x16{};o[1]=f32x16{};o[2]=f32x16{};o[3]=f32x16{};
  const f32x16 zero16=f32x16{};
  const int qrel=wid*QBLK+r32;
  #define BMASK(P0,P1,t) do{int jb_=(t)-(NT-6); if(jb_>=0)bmask(P0,P1,jb_,qrel,hi,rt);}while(0)
  #define PKW(P,B) cvtpk_s(P[B],P[B+1])
  f32x16 c0,c1; u32x4 pw0,pw1,pw2,pw3;
  WAIT_BAR(4);
  qkt(c0,c1,Kbase,qr,zero16,r32,hi); BMASK(c0,c1,0);
  { float sacc=0.f;
    #pragma unroll
    for(int r=0;r<16;++r){c0[r]=__builtin_amdgcn_exp2f(c0[r]);c1[r]=__builtin_amdgcn_exp2f(c1[r]);}
    #pragma unroll
    for(int r=0;r<16;++r)sacc+=c0[r]+c1[r];
    l_reg+=sacc;
    pw0=(u32x4){PKW(c0,0),PKW(c0,2),PKW(c0,4),PKW(c0,6)};pw1=(u32x4){PKW(c0,8),PKW(c0,10),PKW(c0,12),PKW(c0,14)};pw2=(u32x4){PKW(c1,0),PKW(c1,2),PKW(c1,4),PKW(c1,6)};pw3=(u32x4){PKW(c1,8),PKW(c1,10),PKW(c1,12),PKW(c1,14)}; }
  WAIT_BAR(0);
  DMA_K(3,0);DMA_V(1,VSLOTB);
  kload8(kf,kp0+SLOTB);
  WAIT_BAR(3);
  int ks_cur=SLOTB, ks_next=2*SLOTB;
  int vs_prev=0, vs_next=2*VSLOTB;
  s16x4 vlo[16],vhi[16];
  #define PAF(k) __builtin_bit_cast(bf16x8,pw##k)
  #define VFR(i) (bf16x8){vlo[i][0],vlo[i][1],vlo[i][2],vlo[i][3],vhi[i][0],vhi[i][1],vhi[i][2],vhi[i][3]}
  #define PIN(x) asm volatile("":"+v"(x))
  #define EX(v) __builtin_amdgcn_exp2f(v)
  #define VRD(i) do{ vlo[i]=vtr(vp_+(((i)>>2)*4096+((i)&3)*1024)); vhi[i]=vtr(vp_+(((i)>>2)*4096+((i)&3)*1024+512)); }while(0)
  #define GA(VI,MF) do{ VRD(VI); SBAR(); MF; SBAR(); }while(0)
  #define GB0(MF,X,E) do{ MF; X[E]=EX(X[E]); X[E+1]=EX(X[E+1]); PIN(X); SBAR(); }while(0)
  #define GB1(MF,X,E,G,GE,PW,IDX) do{ MF; X[E]=EX(X[E]); X[E+1]=EX(X[E+1]); PIN(X); sacc+=G[GE]; sacc+=G[GE+1]; PIN(sacc); PW[IDX]=PKW(G,GE); PIN(PW); SBAR(); }while(0)
  #define KRD(G,j) do{ if(G){ kload2(kf,kp0+ks_next,j); SBAR(); } }while(0)
  #define MF_O(D0,KS) o[D0]=__builtin_amdgcn_mfma_f32_32x32x16_bf16(PAF(KS),VFR((D0)*4+(KS)),o[D0],0,0,0)
  #define STEP2(t,GK,GV,GL) do{ SBAR(); \
    const lds_cptr vp_=vp0+vs_prev; \
    GA(0, c0=__builtin_amdgcn_mfma_f32_32x32x16_bf16(kf[0],qr[0],zero16,0,0,0)); \
    GA(4, c1=__builtin_amdgcn_mfma_f32_32x32x16_bf16(kf[1],qr[0],zero16,0,0,0)); \
    GA(8, c0=__builtin_amdgcn_mfma_f32_32x32x16_bf16(kf[2],qr[1],c0,0,0,0)); \
    GA(12,c1=__builtin_amdgcn_mfma_f32_32x32x16_bf16(kf[3],qr[1],c1,0,0,0)); \
    GA(1, c0=__builtin_amdgcn_mfma_f32_32x32x16_bf16(kf[4],qr[2],c0,0,0,0)); \
    GA(5, c1=__builtin_amdgcn_mfma_f32_32x32x16_bf16(kf[5],qr[2],c1,0,0,0)); \
    GA(9, c0=__builtin_amdgcn_mfma_f32_32x32x16_bf16(kf[6],qr[3],c0,0,0,0)); \
    GA(13,c1=__builtin_amdgcn_mfma_f32_32x32x16_bf16(kf[7],qr[3],c1,0,0,0)); \
    if(GK){DMA_K((t)+3,ks_cur);} if(GV){DMA_V((t)+1,vs_next);} \
    BMASK(c0,c1,t); \
    SBAR(); float sacc=0.f; \
    GB0(MF_O(0,0),c0,0);  VRD(2);  SBAR(); \
    GB0(MF_O(1,0),c0,2);  VRD(6);  SBAR(); \
    KRD(GL,0); GB0(MF_O(2,0),c0,4);  VRD(10); SBAR(); \
    KRD(GL,1); GB0(MF_O(3,0),c0,6);  VRD(14); SBAR(); \
    KRD(GL,2); GB1(MF_O(0,1),c0,8, c0,0,pw0,0); VRD(3);  SBAR(); \
    KRD(GL,3); GB1(MF_O(1,1),c0,10,c0,2,pw0,1); VRD(7);  SBAR(); \
    GB1(MF_O(2,1),c0,12,c0,4,pw0,2); VRD(11); SBAR(); \
    GB1(MF_O(3,1),c0,14,c0,6,pw0,3); VRD(15); SBAR(); \
    GB1(MF_O(0,2),c1,0, c0,8, pw1,0); \
    GB1(MF_O(1,2),c1,2, c0,10,pw1,1); \
    GB1(MF_O(2,2),c1,4, c0,12,pw1,2); \
    GB1(MF_O(3,2),c1,6, c0,14,pw1,3); \
    GB1(MF_O(0,3),c1,8, c1,0,pw2,0); \
    GB1(MF_O(1,3),c1,10,c1,2,pw2,1); \
    GB1(MF_O(2,3),c1,12,c1,4,pw2,2); \
    GB1(MF_O(3,3),c1,14,c1,6,pw2,3); \
    sacc+=c1[8]; sacc+=c1[9]; sacc+=c1[10]; sacc+=c1[11]; sacc+=c1[12]; sacc+=c1[13]; sacc+=c1[14]; sacc+=c1[15]; \
    pw3=(u32x4){PKW(c1,8),PKW(c1,10),PKW(c1,12),PKW(c1,14)}; PIN(pw3); l_reg+=sacc; SBAR(); \
    }while(0)
  #define ROT2() do{ ks_cur=ks_next; ks_next=(ks_next==(NSLOT-1)*SLOTB)?0:ks_next+SLOTB; vs_prev=(vs_prev==(NSLOT-1)*VSLOTB)?0:vs_prev+VSLOTB; vs_next=(vs_next==(NSLOT-1)*VSLOTB)?0:vs_next+VSLOTB; }while(0)
  int t=1;
  asm volatile(MK_ALIGN_ATT);
  for(;t+3<NT;++t){ STEP2(t,true,true,true); WAIT_BAR(3); ROT2(); }
  for(;t<NT;++t){
    STEP2(t,(t+3<NT),(t+1<NT),(t+1<NT));
    if(t+1<NT){ WAIT_BAR(2); } else { WAIT_BAR(0); }
    ROT2();
  }
  { const lds_cptr vp_=vp0+vs_prev;
    #pragma unroll
    for(int d0=0;d0<4;++d0){
      #pragma unroll
      for(int ks=0;ks<4;++ks){ VRD(d0*4+ks); }
      o[d0]=__builtin_amdgcn_mfma_f32_32x32x16_bf16(PAF(0),VFR(d0*4+0),o[d0],0,0,0);
      o[d0]=__builtin_amdgcn_mfma_f32_32x32x16_bf16(PAF(1),VFR(d0*4+1),o[d0],0,0,0);
      o[d0]=__builtin_amdgcn_mfma_f32_32x32x16_bf16(PAF(2),VFR(d0*4+2),o[d0],0,0,0);
      o[d0]=__builtin_amdgcn_mfma_f32_32x32x16_bf16(PAF(3),VFR(d0*4+3),o[d0],0,0,0); } }
  {auto rr=__builtin_amdgcn_permlane32_swap(__float_as_uint(l_reg),__float_as_uint(l_reg),false,false);l_reg=__uint_as_float(rr[0])+__uint_as_float(rr[1]);}
  if(hi==0)wsf[32+r32]=l_reg;
  asm volatile("s_waitcnt lgkmcnt(0)\n\ts_barrier":::"memory");
  float rli[16];
  #pragma unroll
  for(int r=0;r<16;++r)rli[r]=__builtin_amdgcn_rcpf(wsf[32+crow(r,hi)]);
  bf16*Ow=O+(rowbase+q0+wid*QBLK)*OP;
  unsigned long long a0[8],a1[8];
  if constexpr(POST){ const bf16*O0w=O0+(rowbase+q0+wid*QBLK)*OP;
    #pragma unroll
    for(int i=0;i<8;++i){const int row=i*4+(lane>>4),ch=lane&15; const bf16*p0=O0w+(long)row*OP+ch*8;
      a0[i]=__hip_atomic_load((const __attribute__((address_space(1))) unsigned long long*)p0,__ATOMIC_RELAXED,__HIP_MEMORY_SCOPE_AGENT);
      a1[i]=__hip_atomic_load((const __attribute__((address_space(1))) unsigned long long*)(p0+4),__ATOMIC_RELAXED,__HIP_MEMORY_SCOPE_AGENT);} }
  { bf16*stg=(bf16*)(shm)+wid*4096;
    #pragma unroll
    for(int r=0;r<16;++r){const int orow=crow(r,hi);
      #pragma unroll
      for(int d0=0;d0<4;++d0)stg[orow*128+d0*32+r32]=__float2bfloat16(o[d0][r]*rli[r]);}
    asm volatile("s_waitcnt lgkmcnt(0)":::"memory");
    if constexpr(POST){
      typedef float af32x4 __attribute__((ext_vector_type(4))); const int ch=lane&15; const af32x4 g0=*(const af32x4*)(subg+ch*8),g1=*(const af32x4*)(subg+ch*8+4);
      bf16*Mw=MIXo+(rowbase+q0+wid*QBLK)*1024;
      #pragma unroll
      for(int i=0;i<8;++i){const int row=i*4+(lane>>4); const u32x4 v=*(const u32x4*)(stg+row*128+ch*8);
        const unsigned w0[4]={(unsigned)a0[i],(unsigned)(a0[i]>>32),(unsigned)a1[i],(unsigned)(a1[i]>>32)}; const unsigned w1[4]={v.x,v.y,v.z,v.w};
        float d[8]; float ss=0.f;
        #pragma unroll
        for(int k=0;k<4;++k){ d[2*k]=__uint_as_float(w0[k]<<16)-lam*__uint_as_float(w1[k]<<16); d[2*k+1]=__uint_as_float(w0[k]&0xffff0000u)-lam*__uint_as_float(w1[k]&0xffff0000u); }
        #pragma unroll
        for(int k=0;k<8;++k)ss+=d[k]*d[k];
        ss=att_sum16(ss);
        const float rn=osc*__builtin_amdgcn_rsqf(ss*(1.f/128.f)+1e-6f);
        u32x4 ov; ov.x=cvtpk_s(d[0]*rn*g0[0],d[1]*rn*g0[1]); ov.y=cvtpk_s(d[2]*rn*g0[2],d[3]*rn*g0[3]); ov.z=cvtpk_s(d[4]*rn*g1[0],d[5]*rn*g1[1]); ov.w=cvtpk_s(d[6]*rn*g1[2],d[7]*rn*g1[3]);
        *(u32x4*)(Mw+(long)row*1024+ch*8)=ov; }
    } else {
      #pragma unroll
      for(int i=0;i<8;++i){const int row=i*4+(lane>>4),ch=lane&15; const u32x4 v=*(const u32x4*)(stg+row*128+ch*8); ATTN_STORE16(Ow+(long)row*OP+ch*8,v);} } }
  asm volatile("s_waitcnt lgkmcnt(0)\n\ts_barrier":::"memory");
  #undef DMA_K
  #undef DMA_V
  #undef BMASK
  #undef PKW
  #undef PAF
  #undef VFR
  #undef PIN
  #undef EX
  #undef VRD
  #undef GA
  #undef GB0
  #undef GB1
  #undef KRD
  #undef MF_O
  #undef STEP2
  #undef ROT2
}
constexpr int ATTN2_LDS_BYTES=L2_BYTES;

constexpr int NS3=4;
constexpr int L3_K=0, L3_V=NS3*SLOTB, L3_WS=L3_V+NS3*VSLOTB, L3_BYTES=L3_WS+NW*64*4;
template<int DUMMY> __device__ __forceinline__ void attn_unit3(int b,int qb,const bf16*Q,const bf16*__restrict__ K,const bf16*__restrict__ V,bf16*O,char*shm,const __attribute__((address_space(3))) float*rt){
  int tid_l=threadIdx.x; asm volatile("":"+v"(tid_l)); const int tid=tid_l,lane=tid&63,r32=lane&31,hi=lane>>5; const int wid=__builtin_amdgcn_readfirstlane(tid>>6);
  const long rowbase=(long)b*SEQ; const int q0=qb*QB;
  const bf16*Qw=Q+(rowbase+q0+wid*QBLK)*QP;
  const bf16*Kh=K+rowbase*KP,*Vh=V+rowbase*VP;
  const unsigned lds0=(unsigned)(uintptr_t)shm;
  float*wsf=(float*)(shm+L3_WS)+wid*64;
  const bf16*ksrc=Kh+(long)lane*KP+wid*8;
  const bf16*vsrc=Vh+(long)(16*(wid&3)+(lane>>2))*VP+(wid>>2)*32+(lane&3)*8;
  const unsigned kdst=lds0+L3_K+wid*1024, vdst=lds0+L3_V+wid*1024;
  #define DMA_K(t,slot) glds16(ksrc+(long)(t)*KVBLK*KP,(unsigned)__builtin_amdgcn_readfirstlane(kdst+(slot)))
  #define DMA_V(t,slot) do{ glds16(vsrc+(long)(t)*KVBLK*VP,(unsigned)__builtin_amdgcn_readfirstlane(vdst+(slot))); glds16(vsrc+(long)(t)*KVBLK*VP+64,(unsigned)__builtin_amdgcn_readfirstlane(vdst+(slot)+8192)); }while(0)
  const char*Kbase=shm+L3_K; bf16x8 kf[8];
  const lds_cptr shm3=(lds_cptr)shm; const lds_cptr kp0=shm3+L3_K+hi*1024+r32*16; const lds_cptr vp0=shm3+L3_V+((lane>>4)&1)*32+(lane&3)*8+(4*hi+((lane&15)>>2))*64;
  const int NT=(q0+QB)/KVBLK;
  DMA_K(0,0);DMA_V(0,0);DMA_K(1,SLOTB);
  bf16x8 qr[4];
  #pragma unroll
  for(int d0=0;d0<4;++d0)qr[d0]=*reinterpret_cast<const bf16x8*>(&Qw[(long)r32*QP+d0*16+hi*8]);
  DMA_K(2,2*SLOTB);DMA_V(1,VSLOTB);
  float l_reg=0.f; f32x16 o[4]; o[0]=f32x16{};o[1]=f32x16{};o[2]=f32x16{};o[3]=f32x16{};
  const f32x16 zero16=f32x16{};
  const int qrel=wid*QBLK+r32;
  #define BMASK(P0,P1,t) do{int jb_=(t)-(NT-6); if(jb_>=0)bmask(P0,P1,jb_,qrel,hi,rt);}while(0)
  #define PKW(P,B) cvtpk_s(P[B],P[B+1])
  f32x16 c0,c1; u32x4 pw0,pw1,pw2,pw3;
  WAIT_BAR(3);
  qkt(c0,c1,Kbase,qr,zero16,r32,hi); BMASK(c0,c1,0);
  { float sacc=0.f;
    #pragma unroll
    for(int r=0;r<16;++r){c0[r]=__builtin_amdgcn_exp2f(c0[r]);c1[r]=__builtin_amdgcn_exp2f(c1[r]);}
    #pragma unroll
    for(int r=0;r<16;++r)sacc+=c0[r]+c1[r];
    l_reg+=sacc;
    pw0=(u32x4){PKW(c0,0),PKW(c0,2),PKW(c0,4),PKW(c0,6)};pw1=(u32x4){PKW(c0,8),PKW(c0,10),PKW(c0,12),PKW(c0,14)};pw2=(u32x4){PKW(c1,0),PKW(c1,2),PKW(c1,4),PKW(c1,6)};pw3=(u32x4){PKW(c1,8),PKW(c1,10),PKW(c1,12),PKW(c1,14)}; }
  WAIT_BAR(0);
  DMA_K(3,3*SLOTB);DMA_V(2,2*VSLOTB);
  kload8(kf,kp0+SLOTB);
  WAIT_BAR(3);
  if(wid>=4){ asm volatile("s_barrier":::"memory"); }
  int ks_next=2*SLOTB, ks_iss=0;
  int vs_prev=0, vs_next=3*VSLOTB;
  s16x4 vlo[16],vhi[16];
  #define PAF(k) __builtin_bit_cast(bf16x8,pw##k)
  #define VFR(i) (bf16x8){vlo[i][0],vlo[i][1],vlo[i][2],vlo[i][3],vhi[i][0],vhi[i][1],vhi[i][2],vhi[i][3]}
  #define PIN(x) asm volatile("":"+v"(x))
  #define EX(v) __builtin_amdgcn_exp2f(v)
  #define VRD(i) do{ vlo[i]=vtr(vp_+(((i)>>2)*4096+((i)&3)*1024)); vhi[i]=vtr(vp_+(((i)>>2)*4096+((i)&3)*1024+512)); }while(0)
  #define GA(VI,MF) do{ VRD(VI); SBAR(); MF; SBAR(); }while(0)
  #define GB0(MF,X,E) do{ MF; X[E]=EX(X[E]); X[E+1]=EX(X[E+1]); PIN(X); SBAR(); }while(0)
  #define GB1(MF,X,E,G,GE,PW,IDX) do{ MF; X[E]=EX(X[E]); X[E+1]=EX(X[E+1]); PIN(X); sacc+=G[GE]; sacc+=G[GE+1]; PIN(sacc); PW[IDX]=PKW(G,GE); PIN(PW); SBAR(); }while(0)
  #define KRD(G,j) do{ if(G){ kload2(kf,kp0+ks_next,j); SBAR(); } }while(0)
  #define MF_O(D0,KS) o[D0]=__builtin_amdgcn_mfma_f32_32x32x16_bf16(PAF(KS),VFR((D0)*4+(KS)),o[D0],0,0,0)
  #define STEP2(t,GK,GV,GL) do{ SBAR(); \
    const lds_cptr vp_=vp0+vs_prev; \
    GA(0, c0=__builtin_amdgcn_mfma_f32_32x32x16_bf16(kf[0],qr[0],zero16,0,0,0)); \
    GA(4, c1=__builtin_amdgcn_mfma_f32_32x32x16_bf16(kf[1],qr[0],zero16,0,0,0)); \
    GA(8, c0=__builtin_amdgcn_mfma_f32_32x32x16_bf16(kf[2],qr[1],c0,0,0,0)); \
    GA(12,c1=__builtin_amdgcn_mfma_f32_32x32x16_bf16(kf[3],qr[1],c1,0,0,0)); \
    GA(1, c0=__builtin_amdgcn_mfma_f32_32x32x16_bf16(kf[4],qr[2],c0,0,0,0)); \
    GA(5, c1=__builtin_amdgcn_mfma_f32_32x32x16_bf16(kf[5],qr[2],c1,0,0,0)); \
    GA(9, c0=__builtin_amdgcn_mfma_f32_32x32x16_bf16(kf[6],qr[3],c0,0,0,0)); \
    GA(13,c1=__builtin_amdgcn_mfma_f32_32x32x16_bf16(kf[7],qr[3],c1,0,0,0)); \
    BMASK(c0,c1,t); \
    asm volatile("s_barrier":::"memory"); \
    if(GK){DMA_K((t)+3,ks_iss);} if(GV){DMA_V((t)+2,vs_next);} \
    SBAR(); float sacc=0.f; \
    GB0(MF_O(0,0),c0,0);  VRD(2);  SBAR(); \
    GB0(MF_O(1,0),c0,2);  VRD(6);  SBAR(); \
    KRD(GL,0); GB0(MF_O(2,0),c0,4);  VRD(10); SBAR(); \
    KRD(GL,1); GB0(MF_O(3,0),c0,6);  VRD(14); SBAR(); \
    KRD(GL,2); GB1(MF_O(0,1),c0,8, c0,0,pw0,0); VRD(3);  SBAR(); \
    KRD(GL,3); GB1(MF_O(1,1),c0,10,c0,2,pw0,1); VRD(7);  SBAR(); \
    GB1(MF_O(2,1),c0,12,c0,4,pw0,2); VRD(11); SBAR(); \
    GB1(MF_O(3,1),c0,14,c0,6,pw0,3); VRD(15); SBAR(); \
    GB1(MF_O(0,2),c1,0, c0,8, pw1,0); \
    GB1(MF_O(1,2),c1,2, c0,10,pw1,1); \
    GB1(MF_O(2,2),c1,4, c0,12,pw1,2); \
    GB1(MF_O(3,2),c1,6, c0,14,pw1,3); \
    GB1(MF_O(0,3),c1,8, c1,0,pw2,0); \
    GB1(MF_O(1,3),c1,10,c1,2,pw2,1); \
    GB1(MF_O(2,3),c1,12,c1,4,pw2,2); \
    GB1(MF_O(3,3),c1,14,c1,6,pw2,3); \
    sacc+=c1[8]; sacc+=c1[9]; sacc+=c1[10]; sacc+=c1[11]; sacc+=c1[12]; sacc+=c1[13]; sacc+=c1[14]; sacc+=c1[15]; \
    pw3=(u32x4){PKW(c1,8),PKW(c1,10),PKW(c1,12),PKW(c1,14)}; PIN(pw3); l_reg+=sacc; SBAR(); \
    }while(0)
  #define ROT2() do{ ks_next=(ks_next==(NS3-1)*SLOTB)?0:ks_next+SLOTB; ks_iss=(ks_iss==(NS3-1)*SLOTB)?0:ks_iss+SLOTB; vs_prev=(vs_prev==(NS3-1)*VSLOTB)?0:vs_prev+VSLOTB; vs_next=(vs_next==(NS3-1)*VSLOTB)?0:vs_next+VSLOTB; }while(0)
  int t=1;
  for(;t+3<NT;++t){ STEP2(t,true,true,true); WAIT_BAR(3); ROT2(); }
  for(;t<NT;++t){
    STEP2(t,false,(t+2<NT),(t+1<NT));
    if(t+2<NT){ WAIT_BAR(2); } else { WAIT_BAR(0); }
    ROT2();
  }
  if(wid<4){ asm volatile("s_barrier":::"memory"); }
  { const lds_cptr vp_=vp0+vs_prev;
    #pragma unroll
    for(int d0=0;d0<4;++d0){
      #pragma unroll
      for(int ks=0;ks<4;++ks){ VRD(d0*4+ks); }
      o[d0]=__builtin_amdgcn_mfma_f32_32x32x16_bf16(PAF(0),VFR(d0*4+0),o[d0],0,0,0);
      o[d0]=__builtin_amdgcn_mfma_f32_32x32x16_bf16(PAF(1),VFR(d0*4+1),o[d0],0,0,0);
      o[d0]=__builtin_amdgcn_mfma_f32_32x32x16_bf16(PAF(2),VFR(d0*4+2),o[d0],0,0,0);
      o[d0]=__builtin_amdgcn_mfma_f32_32x32x16_bf16(PAF(3),VFR(d0*4+3),o[d0],0,0,0); } }
  {auto rr=__builtin_amdgcn_permlane32_swap(__float_as_uint(l_reg),__float_as_uint(l_reg),false,false);l_reg=__uint_as_float(rr[0])+__uint_as_float(rr[1]);}
  if(hi==0)wsf[32+r32]=l_reg;
  asm volatile("s_waitcnt lgkmcnt(0)\n\ts_barrier":::"memory");
  float rli[16];
  #pragma unroll
  for(int r=0;r<16;++r)rli[r]=__builtin_amdgcn_rcpf(wsf[32+crow(r,hi)]);
  bf16*Ow=O+(rowbase+q0+wid*QBLK)*OP;
  { bf16*stg=(bf16*)(shm)+wid*4096;
    #pragma unroll
    for(int r=0;r<16;++r){const int orow=crow(r,hi);
      #pragma unroll
      for(int d0=0;d0<4;++d0)stg[orow*128+d0*32+r32]=__float2bfloat16(o[d0][r]*rli[r]);}
    asm volatile("s_waitcnt lgkmcnt(0)":::"memory");
    #pragma unroll
    for(int i=0;i<8;++i){const int row=i*4+(lane>>4),ch=lane&15; const u32x4 v=*(const u32x4*)(stg+row*128+ch*8); ATTN_STORE16(Ow+(long)row*OP+ch*8,v);} }
  asm volatile("s_waitcnt lgkmcnt(0)\n\ts_barrier":::"memory");
  #undef DMA_K
  #undef DMA_V
  #undef BMASK
  #undef PKW
  #undef PAF
  #undef VFR
  #undef PIN
  #undef EX
  #undef VRD
  #undef GA
  #undef GB0
  #undef GB1
  #undef KRD
  #undef MF_O
  #undef STEP2
  #undef ROT2
}
constexpr int ATTN3_LDS_BYTES=L3_BYTES;
constexpr int ATTN_LDS_BYTES=LDS_BYTES;
#undef SBAR
#undef WAIT_BAR
}
#define GAS __attribute__((address_space(1)))
#define LAS __attribute__((address_space(3)))
typedef unsigned short bf16;
typedef unsigned v4u __attribute__((ext_vector_type(4)));
typedef float f32x4 __attribute__((ext_vector_type(4)));
typedef short bf16x8 __attribute__((ext_vector_type(8)));
typedef GAS unsigned gu32;
typedef GAS unsigned long long gu64;
#define RLX_AGENT __ATOMIC_RELAXED, __HIP_MEMORY_SCOPE_AGENT
#define LDS_WAIT() asm volatile("s_waitcnt lgkmcnt(0)" ::: "memory")
#define VM_WAIT() asm volatile("s_waitcnt vmcnt(0)" ::: "memory")
__device__ __forceinline__ unsigned long long rt() { return __builtin_amdgcn_s_memrealtime(); }
__device__ __forceinline__ unsigned f2bf(float f) { unsigned u = __builtin_bit_cast(unsigned, f); return (u + 0x7fffu + ((u >> 16) & 1u)) >> 16; }
__device__ __forceinline__ unsigned pk2(float lo, float hi) { return f2bf(lo) | (f2bf(hi) << 16); }
#define XB_TMO      128
#define XB_XCNT(j)  (256  + 64 * (j))
#define XB_XSUB(j)  (1280 + 64 * (j))
#define XB_XGEN(j)  (2304 + 64 * (j))
#define XB_TOP      3328
#define XB_TOPGEN   3392
#define XCD_BAR_WORDS 3456
#define XB_SPIN_CAP (1u << 18)

__device__ __forceinline__ unsigned xb_ld(unsigned* p)              { return __hip_atomic_load(p, __ATOMIC_RELAXED, __HIP_MEMORY_SCOPE_AGENT); }
__device__ __forceinline__ unsigned xb_add(unsigned* p, unsigned v) { return __hip_atomic_fetch_add(p, v, __ATOMIC_RELAXED, __HIP_MEMORY_SCOPE_AGENT); }
__device__ __forceinline__ unsigned xb_xcc_id() { return (unsigned)__builtin_amdgcn_s_getreg((3 << 11) | 20) & 0xFu; }
#define XB_SPIN(cond, bar) do { unsigned _sp = 0; while (cond) { __builtin_amdgcn_s_sleep(1); \
    if ((++_sp & 255u) == 0u) { if (xb_ld(&(bar)[XB_TMO])) break; if (_sp > XB_SPIN_CAP) { atomicAdd(&(bar)[XB_TMO], 1u); break; } } } } while (0)

struct XcdBarrier {
    unsigned* bar; unsigned x;
    volatile LAS unsigned* st;
};

__device__ __forceinline__ XcdBarrier xcd_barrier_post(unsigned* bar, volatile LAS unsigned* st) {
    XcdBarrier b; b.bar = bar; b.x = xb_xcc_id(); b.st = st;
    if (threadIdx.x == 0) (void)xb_add(&bar[XB_XCNT(b.x)], 1u);
    return b;
}
__device__ __forceinline__ void xcd_barrier_complete(unsigned* bar, unsigned x, unsigned& nloc, unsigned& nx) {
    const unsigned G = gridDim.x * gridDim.y * gridDim.z;
    unsigned sum, cnt, mine, sp = 0u;
    for (;;) {
        sum = 0u; cnt = 0u; mine = 0u;
#pragma unroll
        for (unsigned j = 0; j < 16; ++j) { const unsigned c = xb_ld(&bar[XB_XCNT(j)]); sum += c; cnt += (c > 0u) ? 1u : 0u; mine = (j == x) ? c : mine; }
        if (sum == G) break;
        __builtin_amdgcn_s_sleep(1);
        if ((++sp & 255u) == 0u) { if (xb_ld(&bar[XB_TMO])) break; if (sp > XB_SPIN_CAP) { atomicAdd(&bar[XB_TMO], 1u); break; } }
    }
    nloc = mine > 0u ? mine : 1u; nx = cnt > 0u ? cnt : 1u;
}

__device__ __forceinline__ void xcd_barrier(const XcdBarrier& b) {
    asm volatile("s_waitcnt vmcnt(0)" ::: "memory");
    __syncthreads();
    if (threadIdx.x == 0) {
        unsigned* bar = b.bar;
        __builtin_amdgcn_s_waitcnt(0);
        unsigned nloc = b.st[0], nx = b.st[1];
        if (nloc == 0u) { xcd_barrier_complete(bar, b.x, nloc, nx); b.st[0] = nloc; b.st[1] = nx; }
        const unsigned old = xb_add(&bar[XB_XSUB(b.x)], 1u);
        const unsigned gen = old / nloc;
        if (old + 1u == (gen + 1u) * nloc) {
            __builtin_amdgcn_fence(__ATOMIC_RELEASE, "agent");
            asm volatile("s_waitcnt vmcnt(0)" ::: "memory");
            const unsigned og = xb_add(&bar[XB_TOP], 1u);
            const unsigned tg = og / nx;
            if (og + 1u == (tg + 1u) * nx) xb_add(&bar[XB_TOPGEN], 1u);
            else XB_SPIN(xb_ld(&bar[XB_TOPGEN]) == tg, bar);
            __builtin_amdgcn_fence(__ATOMIC_ACQUIRE, "agent");
            xb_add(&bar[XB_XGEN(b.x)], 1u);
            asm volatile("s_waitcnt vmcnt(0)" ::: "memory");
        } else {
            XB_SPIN(xb_ld(&bar[XB_XGEN(b.x)]) == gen, bar);
            __builtin_amdgcn_fence(__ATOMIC_ACQUIRE, "agent");
            asm volatile("s_waitcnt vmcnt(0)" ::: "memory");
        }
    }
    __syncthreads();
}
typedef float mk_f32x2 __attribute__((ext_vector_type(2))); typedef __bf16 mk_bf16x2 __attribute__((ext_vector_type(2)));
__device__ __forceinline__ unsigned hpk2(float lo, float hi) { const mk_f32x2 v = {lo, hi}; return __builtin_bit_cast(unsigned, __builtin_convertvector(v, mk_bf16x2)); }
__device__ __forceinline__ unsigned hf2bf(float f) { return hpk2(f, 0.f) & 0xffffu; }
#define pk2 hpk2
#define f2bf hf2bf
constexpr int NWAVES = 8;
constexpr int NB = 16, SEQ = 2048, T = NB * SEQ, DM = 1024, DEPTH = 2;
constexpr int NIN = 2576, N1P = 2816, FFN = 2816, NGU = 5632;
constexpr float EPS = 1e-6f;
constexpr float LOG2E = 1.4426950408889634f;
#ifndef PROBE_FLAGS
#define PROBE_FLAGS 0
#endif
#ifndef GLA_RECURRENT
#define GLA_RECURRENT 0
#endif
#ifndef WGM_G1
#define WGM_G1 2
#define WGM_G2 4
#define WGM_G3 4
#define WGM_G4 4
#endif
#ifndef ATT_V2
#define ATT_V2 1
#endif
constexpr size_t MiB = 1u << 20;
constexpr size_t WS_CTL = 0, CTL_ZERO_BYTES = 64 * 1024;
constexpr size_t WS_RSA = 1 * MiB, WS_RSF = 3 * MiB, WS_GLR = 5 * MiB, WS_DEC = 6 * MiB, WS_PWT = 7 * MiB;
constexpr size_t WS_W = 8 * MiB, W_LAYER = 24 * MiB;
constexpr size_t WO_W1 = 0, WO_WO = 5632 * 1024, WO_WGU = WO_WO + 2 * MiB, WO_WD = WO_WGU + 11 * MiB;
static_assert(WO_WD + 5632 * 1024 == W_LAYER, "weights map");
constexpr size_t WS_HB = 56 * MiB;
constexpr size_t WS_Q = 120 * MiB, WS_K = 152 * MiB, WS_V = 184 * MiB;
constexpr size_t WS_GQK = 216 * MiB, WS_GV = 232 * MiB, WS_GR = 248 * MiB, WS_PU = 264 * MiB;
constexpr size_t WS_MIX = 280 * MiB;
constexpr size_t WS_OSCR = 344 * MiB;
constexpr size_t WS_KV = 408 * MiB;
constexpr size_t WS_AG = 424 * MiB;
constexpr size_t WS_FF = 120 * MiB;
constexpr size_t WS_END = 440 * MiB;
constexpr int CW_BAR = 1024;
constexpr int RING_OFF = 0, RING_BYTES = 131072;
constexpr int LDSCTL_OFF = RING_BYTES, MISC_OFF = LDSCTL_OFF + 320;
constexpr int LDS_BYTES = 147456;
constexpr int RST_OFF = LDSCTL_OFF + 1024;
static_assert(RST_OFF + 11 * 256 * 4 <= LDS_BYTES, "row-factor table");
constexpr int ATT_RT_OFF = 102400;
constexpr int ATT_LAM_OFF = ATT_RT_OFF + 4 * 640 * 4;
static_assert(attn_body::ATTN_LDS_BYTES <= ATT_RT_OFF && attn_body::ATTN2_LDS_BYTES <= ATT_RT_OFF && attn_body::ATTN3_LDS_BYTES <= ATT_RT_OFF && ATT_LAM_OFF + 64 <= RING_BYTES, "attention LDS map");

struct Frame {
    LAS unsigned char* lds;
    volatile LAS unsigned* MISC;
    gu32* ctl;
    int tid, lane, wave;
    int vcu, G;
};
struct Args { const float* in[18]; float* out; unsigned char* ws; int ph_lo, ph_hi, flags, bar_region; };
enum { I_X = 0, I_ATTN_G, I_WIN, I_QG, I_KG, I_LV, I_SUBG, I_RELB, I_GGW, I_GGB, I_GNG, I_PW, I_PS, I_WOUT, I_FFN_G, I_WG, I_WU, I_WD };

__device__ __forceinline__ float wave_sum(float v) {
#pragma unroll
    for (int o = 1; o < 64; o <<= 1) v += __shfl_xor(v, o);
    return v;
}
__device__ __forceinline__ float bf2f(bf16 v) { return __builtin_bit_cast(float, (unsigned)v << 16); }
__host__ __device__ __forceinline__ int w1_src_col(int p) {
    if (p >= 2576) return -1;
    if (p >= 2560) return 2048 + (p - 2560);
    const int pn = p >> 8, q = p & 255, bj = q >> 7, wc = (q >> 5) & 3, j = q & 31;
    const int L = 256 * pn + 64 * wc + 32 * bj + j;
    return L < 2048 ? L : L + 16;
}
__device__ __forceinline__ int t5_bucket(int d) {
    if (d < 16) return d;
    const int large = 16 + (int)(logf((float)d / 16.f) / 2.0794415416798357f * 16.f);
    return large < 31 ? large : 31;
}
__device__ __forceinline__ float lam_of(const float* lv, int layer, float& lam_init) {
    float s01 = 0.f, s23 = 0.f;
    for (int i = 0; i < 64; ++i) { s01 += lv[i] * lv[64 + i]; s23 += lv[128 + i] * lv[192 + i]; }
    lam_init = 0.8f - 0.6f * expf(-0.3f * (float)layer);
    return expf(s01) - expf(s23) + lam_init;
}

__device__ __forceinline__ void tr_item(const float* W, int ldw, int srcc, int nvalid, const float* g, int K, bf16* WT, int drow, LAS float* scr, int k0, int lane) {
    { const int n = lane & 31, kh = lane >> 5; float v[32];
#pragma unroll
      for (int i = 0; i < 32; ++i) v[i] = (n < nvalid) ? __builtin_nontemporal_load(&W[(size_t)(k0 + 2 * i + kh) * ldw + srcc + n]) : 0.f;
      if (g) {
#pragma unroll
          for (int i = 0; i < 32; ++i) v[i] *= g[k0 + 2 * i + kh]; }
#pragma unroll
      for (int i = 0; i < 32; ++i) scr[(2 * i + kh) * 33 + n] = v[i]; }
    LDS_WAIT(); asm volatile("" ::: "memory");
    const int c = lane & 7;
#pragma unroll
    for (int j = 0; j < 4; ++j) { const int n = (lane >> 3) + 8 * j; const LAS float* s = scr + (8 * c) * 33 + n;
        v4u o; o.x = pk2(s[0 * 33], s[1 * 33]); o.y = pk2(s[2 * 33], s[3 * 33]); o.z = pk2(s[4 * 33], s[5 * 33]); o.w = pk2(s[6 * 33], s[7 * 33]);
        *(GAS v4u*)(WT + (size_t)(drow + n) * K + k0 + 8 * c) = o; }
    LDS_WAIT(); asm volatile("" ::: "memory");
}
constexpr int P0_I1 = 16 * 88;
__device__ __forceinline__ void p0_weight_items(Frame& F, const Args& a, int it0, int it1, int gw_, int NGW_) {
    LAS float* scr = (LAS float*)(F.lds + RING_OFF + F.wave * 16384);
    constexpr int I1 = P0_I1, I2 = 16 * 32, I3 = 16 * 176, I4 = 44 * 32, IL = I1 + I2 + I3 + I4;
    for (int it = it0 + gw_; it < it1; it += NGW_) {
        const int l = it / IL; int r = it % IL;
        bf16* wl = (bf16*)(a.ws + WS_W + (size_t)l * W_LAYER);
        if (r < I1) { const int kb = r / 88, nb = r % 88, p0 = 32 * nb; int src = 0, nv = 0;
            if (nb < 80) { src = w1_src_col(p0); nv = 32; } else if (nb == 80) { src = 2048; nv = 16; }
            tr_item(a.in[I_WIN] + (size_t)l * DM * NIN, NIN, src, nv, a.in[I_ATTN_G] + l * DM, DM, wl + WO_W1 / 2, p0, scr, 64 * kb, F.lane); continue; }
        r -= I1;
        if (r < I2) { const int kb = r / 32, nb = r % 32;
            tr_item(a.in[I_WOUT] + (size_t)l * DM * DM, DM, 32 * nb, 32, nullptr, DM, wl + WO_WO / 2, 32 * nb, scr, 64 * kb, F.lane); continue; }
        r -= I2;
        if (r < I3) { const int kb = r / 176, nb = r % 176, p0 = 32 * nb, pn = p0 >> 8, bj = (p0 >> 7) & 1, jj = p0 & 127;
            tr_item((bj ? a.in[I_WU] : a.in[I_WG]) + (size_t)l * DM * FFN, FFN, 128 * pn + jj, 32, a.in[I_FFN_G] + l * DM, DM, wl + WO_WGU / 2, p0, scr, 64 * kb, F.lane); continue; }
        r -= I3;
        { const int kb = r / 32, nb = r % 32;
            tr_item(a.in[I_WD] + (size_t)l * FFN * DM, DM, 32 * nb, 32, nullptr, FFN, wl + WO_WD / 2, 32 * nb, scr, 64 * kb, F.lane); }
    }
}
constexpr int P0_ITEMS = DEPTH * (16 * 88 + 16 * 32 + 16 * 176 + 44 * 32);
__device__ __forceinline__ void p0_prologue(Frame& F, const Args& a) {
    const int gw = F.vcu * NWAVES + F.wave, NGW = F.G * NWAVES;
    p0_weight_items(F, a, 0, P0_I1, gw, NGW);
    bf16* HB = (bf16*)(a.ws + WS_HB); float* RSA = (float*)(a.ws + WS_RSA);
    for (int m = gw; m < T; m += 2 * NGW) {
        const int m2 = m + NGW;
        const GAS f32x4* xr = (const GAS f32x4*)(a.in[I_X] + (size_t)m * DM) + F.lane; const GAS f32x4* xr2 = (const GAS f32x4*)(a.in[I_X] + (size_t)(m2 < T ? m2 : m) * DM) + F.lane;
        f32x4 v[4], w[4]; float s = 0.f, s2 = 0.f;
#pragma unroll
        for (int j = 0; j < 4; ++j) { v[j] = __builtin_nontemporal_load(&xr[64 * j]); w[j] = __builtin_nontemporal_load(&xr2[64 * j]); }
#pragma unroll
        for (int j = 0; j < 4; ++j) { s += (v[j].x * v[j].x + v[j].y * v[j].y) + (v[j].z * v[j].z + v[j].w * v[j].w); s2 += (w[j].x * w[j].x + w[j].y * w[j].y) + (w[j].z * w[j].z + w[j].w * w[j].w); }
        s = wave_sum(s); s2 = wave_sum(s2);
        GAS unsigned long long* o8 = (GAS unsigned long long*)(HB + (size_t)m * DM) + F.lane;
#pragma unroll
        for (int j = 0; j < 4; ++j) o8[64 * j] = (unsigned long long)pk2(v[j].x, v[j].y) | ((unsigned long long)pk2(v[j].z, v[j].w) << 32);
        if (F.lane < 16) RSA[(size_t)m * 16 + F.lane] = (F.lane == 0) ? s : 0.f;
        if (m2 < T) { GAS unsigned long long* p8 = (GAS unsigned long long*)(HB + (size_t)m2 * DM) + F.lane;
#pragma unroll
            for (int j = 0; j < 4; ++j) p8[64 * j] = (unsigned long long)pk2(w[j].x, w[j].y) | ((unsigned long long)pk2(w[j].z, w[j].w) << 32);
            if (F.lane < 16) RSA[(size_t)m2 * 16 + F.lane] = (F.lane == 0) ? s2 : 0.f; }
    }
    { bf16* PWT = (bf16*)(a.ws + WS_PWT);
      for (int idx = gw * 64 + F.lane; idx < DEPTH * 4 * 64 * 64; idx += NGW * 64) { const int l = idx >> 14, g = (idx >> 12) & 3, dd = (idx >> 6) & 63, c = idx & 63;
          PWT[idx] = (bf16)f2bf(a.in[I_PW][((l * 4 + g) * 64 + c) * 64 + dd] * a.in[I_PS][l * 256 + g * 64 + dd]); } }
}


typedef float f32x16 __attribute__((ext_vector_type(16)));
typedef unsigned long long u64;
constexpr int GLA_TS = 72;
constexpr int GLA_VT_OFF = 32 * GLA_TS * 2;
constexpr int GLA_GW_OFF = GLA_VT_OFF + 64 * GLA_TS * 2;
__device__ __forceinline__ void gla_vt_load(const bf16* GV, size_t row, int h, v4u (&w)[8]) {
    const GAS v4u* vp = (const GAS v4u*)(GV + row * 256 + h * 64);
#pragma unroll
    for (int i = 0; i < 8; ++i) w[i] = vp[i];
}
__device__ __forceinline__ void gla_vt_store(const v4u (&w)[8], int lane, LAS bf16* VT) {
#pragma unroll
    for (int i = 0; i < 8; ++i) { const unsigned ws_[4] = {w[i].x, w[i].y, w[i].z, w[i].w};
#pragma unroll
        for (int k = 0; k < 4; ++k) { VT[(8 * i + 2 * k) * GLA_TS + lane] = (bf16)(ws_[k] & 0xffffu); VT[(8 * i + 2 * k + 1) * GLA_TS + lane] = (bf16)(ws_[k] >> 16); } }
}
__device__ __forceinline__ void gla_chunk_A(unsigned char* ws, const float* gw, const float* gb, int c, int lane, LAS unsigned char* scr) {
    const int bh = c >> 5, n = c & 31, b = bh >> 2, h = bh & 3;
    const size_t row = (size_t)b * SEQ + n * 64 + lane;
    const bf16* GLR = (const bf16*)(ws + WS_GLR); const bf16* GQK = (const bf16*)(ws + WS_GQK); const bf16* GV = (const bf16*)(ws + WS_GV);
    const int r32 = lane & 31, hh = lane >> 5;
    const bf16x8 lrB0 = *(const GAS bf16x8*)(GLR + (row - lane + r32) * 16 + 8 * hh), lrB1 = *(const GAS bf16x8*)(GLR + (row - lane + 32 + r32) * 16 + 8 * hh);
    v4u kw[4], vw[8];
    { const GAS v4u* kp = (const GAS v4u*)(GQK + row * 256 + 128 + h * 32);
#pragma unroll
      for (int i = 0; i < 4; ++i) kw[i] = kp[i]; }
    gla_vt_load(GV, row, h, vw);
    float gwr[8]; f32x4 gb4[4];
#pragma unroll
    for (int j = 0; j < 8; ++j) gwr[j] = gw[(8 * hh + j) * 128 + h * 32 + r32];
#pragma unroll
    for (int g = 0; g < 4; ++g) gb4[g] = *(const f32x4*)(gb + h * 32 + 8 * g + 4 * hh);
    asm volatile("" ::: "memory");
    float la[32];
    { unsigned wh[4], wl[4];
#pragma unroll
      for (int i = 0; i < 4; ++i) { wh[i] = pk2(gwr[2 * i], gwr[2 * i + 1]);
          wl[i] = pk2(gwr[2 * i] - __builtin_bit_cast(float, wh[i] << 16), gwr[2 * i + 1] - __builtin_bit_cast(float, wh[i] & 0xffff0000u)); }
      const bf16x8 Ah = __builtin_bit_cast(bf16x8, (v4u){wh[0], wh[1], wh[2], wh[3]}), Al = __builtin_bit_cast(bf16x8, (v4u){wl[0], wl[1], wl[2], wl[3]});
      f32x16 z0, z1;
#pragma unroll
      for (int p = 0; p < 16; ++p) { z0[p] = gb4[p >> 2][p & 3]; z1[p] = gb4[p >> 2][p & 3]; }
      z0 = __builtin_amdgcn_mfma_f32_32x32x16_bf16(Ah, lrB0, z0, 0, 0, 0); z1 = __builtin_amdgcn_mfma_f32_32x32x16_bf16(Ah, lrB1, z1, 0, 0, 0);
      z0 = __builtin_amdgcn_mfma_f32_32x32x16_bf16(Al, lrB0, z0, 0, 0, 0); z1 = __builtin_amdgcn_mfma_f32_32x32x16_bf16(Al, lrB1, z1, 0, 0, 0);
#pragma unroll
      for (int p = 0; p < 16; ++p) { const float f0 = z0[p], f1 = z1[p];
          const auto sw = __builtin_amdgcn_permlane32_swap(__float_as_uint(f0), __float_as_uint(f1), false, false);
          const unsigned s0_ = sw[0], s1_ = sw[1]; la[(p & 3) + 8 * (p >> 2)] = __uint_as_float(s0_); la[(p & 3) + 8 * (p >> 2) + 4] = __uint_as_float(s1_); } }
#pragma unroll
    for (int d = 0; d < 32; ++d) { const float z = la[d]; la[d] = (fminf(z, 0.f) - 0.6931471805599453f * __builtin_amdgcn_logf(1.f + __builtin_amdgcn_exp2f(-1.4426950408889634f * fabsf(z)))) * (1.f / 16.f); }
    LAS float* A = (LAS float*)scr;
#pragma unroll
    for (int d4 = 0; d4 < 8; ++d4) *(LAS f32x4*)(A + lane * 36 + 4 * d4) = (f32x4){la[4 * d4], la[4 * d4 + 1], la[4 * d4 + 2], la[4 * d4 + 3]};
    LDS_WAIT(); __builtin_amdgcn_wave_barrier(); asm volatile("" ::: "memory");
    { const int dd = lane & 31, hf = lane >> 5; float v[32];
#pragma unroll
      for (int i = 0; i < 32; ++i) v[i] = A[(32 * hf + i) * 36 + dd];
#pragma unroll
      for (int i = 1; i < 32; ++i) v[i] += v[i - 1];
      const float carry = __shfl_xor(v[31], 32);
      if (hf) {
#pragma unroll
          for (int i = 0; i < 32; ++i) v[i] += carry; }
#pragma unroll
      for (int i = 0; i < 32; ++i) A[(32 * hf + i) * 36 + dd] = v[i]; }
    LDS_WAIT(); __builtin_amdgcn_wave_barrier(); asm volatile("" ::: "memory");
    float Bd[32];
#pragma unroll
    for (int d4 = 0; d4 < 8; ++d4) { const f32x4 a4 = *(const LAS f32x4*)(A + lane * 36 + 4 * d4), b4 = *(const LAS f32x4*)(A + 63 * 36 + 4 * d4);
        la[4 * d4] = a4[0]; la[4 * d4 + 1] = a4[1]; la[4 * d4 + 2] = a4[2]; la[4 * d4 + 3] = a4[3]; Bd[4 * d4] = b4[0]; Bd[4 * d4 + 1] = b4[1]; Bd[4 * d4 + 2] = b4[2]; Bd[4 * d4 + 3] = b4[3]; }
    if (lane < 32) ((float*)(ws + WS_DEC))[(size_t)c * 32 + lane] = __expf(A[63 * 36 + lane]);
    LDS_WAIT(); __builtin_amdgcn_wave_barrier(); asm volatile("" ::: "memory");
    { float* BC = (float*)(ws + WS_AG) + row * 128 + h * 32;
#pragma unroll
      for (int i = 0; i < 8; ++i) *(GAS f32x4*)(BC + 4 * i) = (f32x4){la[4 * i], la[4 * i + 1], la[4 * i + 2], la[4 * i + 3]}; }
    LAS bf16* KeT = (LAS bf16*)scr; LAS bf16* VT = (LAS bf16*)(scr + GLA_VT_OFF);
    {
#pragma unroll
      for (int i = 0; i < 4; ++i) { const v4u w = kw[i]; const unsigned ws_[4] = {w.x, w.y, w.z, w.w};
#pragma unroll
          for (int k = 0; k < 4; ++k) {
#pragma unroll
              for (int e = 0; e < 2; ++e) { const int d = 8 * i + 2 * k + e; const float kv = e ? __builtin_bit_cast(float, ws_[k] & 0xffff0000u) : __builtin_bit_cast(float, ws_[k] << 16);
                  KeT[d * GLA_TS + lane] = (bf16)f2bf(kv * __expf(Bd[d] - la[d])); } } } }
    gla_vt_store(vw, lane, VT);
    LDS_WAIT(); __builtin_amdgcn_wave_barrier(); asm volatile("" ::: "memory");
    const int r = r32;
    float* KV = (float*)(ws + WS_KV) + (size_t)c * 2048;
#pragma unroll
    for (int vb = 0; vb < 2; ++vb) {
        f32x16 acc = {};
#pragma unroll
        for (int s_ = 0; s_ < 4; ++s_) {
            const bf16x8 A = *(const LAS bf16x8*)(KeT + r * GLA_TS + 16 * s_ + 8 * hh);
            const bf16x8 B = *(const LAS bf16x8*)(VT + (32 * vb + r) * GLA_TS + 16 * s_ + 8 * hh);
            acc = __builtin_amdgcn_mfma_f32_32x32x16_bf16(A, B, acc, 0, 0, 0);
        }
#pragma unroll
        for (int g = 0; g < 4; ++g) *(GAS f32x4*)(KV + ((vb * 4 + g) * 64 + lane) * 4) = (f32x4){acc[4 * g], acc[4 * g + 1], acc[4 * g + 2], acc[4 * g + 3]};
    }
    LDS_WAIT(); __builtin_amdgcn_wave_barrier(); asm volatile("" ::: "memory");
}

constexpr int GLA_SCR = 9216;
constexpr int GLA_SNAP_OFF = NWAVES * GLA_SCR;
__device__ __forceinline__ void gla_state_scan(unsigned char* ws, int c0, int q, int lane, LAS u64* snapall) {
    const int n0 = c0 & 31, cb = c0 - n0, g = q & 3, hh = lane >> 5;
    const float* DEC = (const float*)(ws + WS_DEC) + (size_t)cb * 32 + 8 * g + 4 * hh; const float* KV = (const float*)(ws + WS_KV) + (size_t)cb * 2048 + q * 256 + lane * 4;
    f32x4 S = {0.f, 0.f, 0.f, 0.f};
    const int ne = n0 + 7;
    for (int jb = 0; jb < ne; jb += 16) {
        f32x4 dq[16], kv[16];
#pragma unroll
        for (int u = 0; u < 16; ++u) { const int e = (jb + u < ne) ? jb + u : ne - 1; dq[u] = *(const GAS f32x4*)(DEC + e * 32); kv[u] = *(const GAS f32x4*)(KV + (size_t)e * 2048); }
#pragma unroll
        for (int u = 0; u < 16; ++u) { const int e = jb + u;
            if (e >= n0 && e <= ne) snapall[((e - n0) * 8 + q) * 64 + lane] = (u64)pk2(S[0], S[1]) | ((u64)pk2(S[2], S[3]) << 32);
            if (e < ne) S = S * dq[u] + kv[u]; }
    }
    if ((ne & 15) == 0) snapall[(7 * 8 + q) * 64 + lane] = (u64)pk2(S[0], S[1]) | ((u64)pk2(S[2], S[3]) << 32);
}
__device__ __forceinline__ bf16x8 pack8(float a0, float a1, float a2, float a3, float a4, float a5, float a6, float a7) {
    const unsigned w0 = pk2(a0, a1), w1 = pk2(a2, a3), w2 = pk2(a4, a5), w3 = pk2(a6, a7);
    return __builtin_bit_cast(bf16x8, (v4u){w0, w1, w2, w3});
}
__device__ __forceinline__ void gla_chunk_C(unsigned char* ws, const float* gng, int c, int lane, LAS unsigned char* scr, const LAS u64* snap) {
    const int bh = c >> 5, n = c & 31, b = bh >> 2, h = bh & 3, r = lane & 31, hh = lane >> 5;
    const size_t row0 = (size_t)b * SEQ + n * 64;
    const bf16* GQK = (const bf16*)(ws + WS_GQK); const bf16* GV = (const bf16*)(ws + WS_GV); const bf16* GR = (const bf16*)(ws + WS_GR);
    const float* BC = (const float*)(ws + WS_AG); bf16* MIX = (bf16*)(ws + WS_MIX);
    LAS bf16* VT = (LAS bf16*)scr;
    v4u vw[8]; gla_vt_load(GV, row0 + lane, h, vw);
    u64 q4s[2][2][2], k4s[2][2][2]; f32x4 b4s[2][2][2]; u64 g4s[2][2][4];
#pragma unroll
    for (int bj = 0; bj < 2; ++bj) { const size_t trow = row0 + 32 * bj + r;
#pragma unroll
        for (int s_ = 0; s_ < 2; ++s_)
#pragma unroll
            for (int g = 0; g < 2; ++g) { const int d0 = 16 * s_ + 8 * g + 4 * hh;
                q4s[bj][s_][g] = *(const GAS u64*)(GQK + trow * 256 + h * 32 + d0); k4s[bj][s_][g] = *(const GAS u64*)(GQK + trow * 256 + 128 + h * 32 + d0);
                b4s[bj][s_][g] = *(const GAS f32x4*)(BC + trow * 128 + h * 32 + d0); }
#pragma unroll
        for (int vb = 0; vb < 2; ++vb)
#pragma unroll
            for (int g = 0; g < 4; ++g) g4s[bj][vb][g] = *(const GAS u64*)(GR + trow * 256 + h * 64 + 32 * vb + 8 * g + 4 * hh); }
    asm volatile("" ::: "memory");
    gla_vt_store(vw, lane, VT);
    bf16x8 QdF[2][2], KiF[2][2];
    const float scale = 0.17677669529663687f;
#pragma unroll
    for (int bj = 0; bj < 2; ++bj) {
#pragma unroll
        for (int s_ = 0; s_ < 2; ++s_) { float qd[8], ki[8];
#pragma unroll
            for (int g = 0; g < 2; ++g) { const u64 q4 = q4s[bj][s_][g], k4 = k4s[bj][s_][g]; const f32x4 b4 = b4s[bj][s_][g];
#pragma unroll
                for (int x = 0; x < 4; ++x) { const float qv = bf2f((bf16)(q4 >> (16 * x))), kv = bf2f((bf16)(k4 >> (16 * x)));
                    qd[4 * g + x] = qv * scale * __expf(b4[x]); ki[4 * g + x] = kv * __expf(-b4[x]); } }
            QdF[bj][s_] = pack8(qd[0], qd[1], qd[2], qd[3], qd[4], qd[5], qd[6], qd[7]);
            KiF[bj][s_] = pack8(ki[0], ki[1], ki[2], ki[3], ki[4], ki[5], ki[6], ki[7]); } }
    bf16x8 SA[2][2];
#pragma unroll
    for (int vb = 0; vb < 2; ++vb)
#pragma unroll
        for (int s_ = 0; s_ < 2; ++s_) { const u64 lo = snap[(vb * 4 + 2 * s_) * 64 + lane], hi = snap[(vb * 4 + 2 * s_ + 1) * 64 + lane];
            SA[vb][s_] = __builtin_bit_cast(bf16x8, (v4u){(unsigned)lo, (unsigned)(lo >> 32), (unsigned)hi, (unsigned)(hi >> 32)}); }
    f32x16 X00 = {}, X01 = {}, X11 = {};
#pragma unroll
    for (int s_ = 0; s_ < 2; ++s_) { X00 = __builtin_amdgcn_mfma_f32_32x32x16_bf16(KiF[0][s_], QdF[0][s_], X00, 0, 0, 0);
        X01 = __builtin_amdgcn_mfma_f32_32x32x16_bf16(KiF[0][s_], QdF[1][s_], X01, 0, 0, 0); X11 = __builtin_amdgcn_mfma_f32_32x32x16_bf16(KiF[1][s_], QdF[1][s_], X11, 0, 0, 0); }
#pragma unroll
    for (int p = 0; p < 16; ++p) { const int tk = (p & 3) + 8 * (p >> 2) + 4 * hh; if (tk > r) { X00[p] = 0.f; X11[p] = 0.f; } }
    bf16x8 XB00[2], XB01[2], XB11[2];
#pragma unroll
    for (int s_ = 0; s_ < 2; ++s_) { const int o = 8 * s_;
        XB00[s_] = pack8(X00[o], X00[o + 1], X00[o + 2], X00[o + 3], X00[o + 4], X00[o + 5], X00[o + 6], X00[o + 7]);
        XB01[s_] = pack8(X01[o], X01[o + 1], X01[o + 2], X01[o + 3], X01[o + 4], X01[o + 5], X01[o + 6], X01[o + 7]);
        XB11[s_] = pack8(X11[o], X11[o + 1], X11[o + 2], X11[o + 3], X11[o + 4], X11[o + 5], X11[o + 6], X11[o + 7]); }
    LDS_WAIT(); __builtin_amdgcn_wave_barrier(); asm volatile("" ::: "memory");
    f32x16 OT[2][2];
#pragma unroll
    for (int vb = 0; vb < 2; ++vb)
#pragma unroll
        for (int bj = 0; bj < 2; ++bj) { f32x16 o = {};
#pragma unroll
            for (int s_ = 0; s_ < 2; ++s_) o = __builtin_amdgcn_mfma_f32_32x32x16_bf16(SA[vb][s_], QdF[bj][s_], o, 0, 0, 0);
#pragma unroll
            for (int bi = 0; bi <= bj; ++bi)
#pragma unroll
                for (int s_ = 0; s_ < 2; ++s_) { const LAS bf16* p = VT + (32 * vb + r) * GLA_TS + 32 * bi + 16 * s_ + 4 * hh;
                    const u64 lo = *(const LAS u64*)p, hi = *(const LAS u64*)(p + 8);
                    const bf16x8 A = __builtin_bit_cast(bf16x8, (v4u){(unsigned)lo, (unsigned)(lo >> 32), (unsigned)hi, (unsigned)(hi >> 32)});
                    const bf16x8 XB = (bi == 0) ? (bj == 0 ? XB00[s_] : XB01[s_]) : XB11[s_];
                    o = __builtin_amdgcn_mfma_f32_32x32x16_bf16(A, XB, o, 0, 0, 0); }
            OT[vb][bj] = o; }
#pragma unroll
    for (int bj = 0; bj < 2; ++bj) { float ss = 0.f;
#pragma unroll
        for (int vb = 0; vb < 2; ++vb)
#pragma unroll
            for (int p = 0; p < 16; ++p) ss = fmaf(OT[vb][bj][p], OT[vb][bj][p], ss);
        ss += __shfl_xor(ss, 32);
        const float rn = __builtin_amdgcn_rsqf(ss * (1.f / 64.f) + EPS); const size_t trow = row0 + 32 * bj + r;
#pragma unroll
        for (int vb = 0; vb < 2; ++vb)
#pragma unroll
            for (int g = 0; g < 4; ++g) { const int v0 = 32 * vb + 8 * g + 4 * hh;
                const u64 g4 = g4s[bj][vb][g]; const f32x4 n4 = *(const f32x4*)(gng + v0); float o4[4];
#pragma unroll
                for (int x = 0; x < 4; ++x) { const float gr = bf2f((bf16)(g4 >> (16 * x))); o4[x] = OT[vb][bj][4 * g + x] * rn * n4[x] * (gr * __builtin_amdgcn_rcpf(1.f + __expf(-gr))); }
                *(GAS u64*)(MIX + trow * DM + 512 + h * 64 + v0) = (u64)pk2(o4[0], o4[1]) | ((u64)pk2(o4[2], o4[3]) << 32); } }
    LDS_WAIT(); __builtin_amdgcn_wave_barrier(); asm volatile("" ::: "memory");
}
__device__ __forceinline__ void p2a_decay_pool(Frame& F, unsigned char* ws, const float* gw_, const float* gb, int l) {
#if GLA_RECURRENT
    const bf16* GLR = (const bf16*)(ws + WS_GLR); float* AG = (float*)(ws + WS_AG);
    const int gt = F.vcu * (NWAVES * 64) + F.tid, NT_ = F.G * NWAVES * 64;
    for (int idx = gt; idx < T * 128; idx += NT_) {
        const int t = idx >> 7, c = idx & 127;
        float z = gb[c];
#pragma unroll
        for (int r = 0; r < 16; ++r) z = fmaf(bf2f(GLR[(size_t)t * 16 + r]), gw_[r * 128 + c], z);
        const float ls = fminf(z, 0.f) - log1pf(expf(-fabsf(z)));
        AG[idx] = expf(ls * (1.f / 16.f));
    }
#else
    for (int c = __builtin_amdgcn_readfirstlane(F.vcu * NWAVES + F.wave); c < NB * 4 * 32; c += F.G * NWAVES) gla_chunk_A(ws, gw_, gb, c, F.lane, F.lds + RING_OFF + F.wave * 16384);
    __syncthreads();
#endif
    {
        const bf16* PU = (const bf16*)(ws + WS_PU); bf16* MIX = (bf16*)(ws + WS_MIX); const bf16* PWT = (const bf16*)(ws + WS_PWT) + l * 16384;
        constexpr int PS_ = 72;
        LAS bf16* Uw = (LAS bf16*)(F.lds + RING_OFF + F.wave * 16384);
        const int r = F.lane & 31, hh = F.lane >> 5, c = F.lane;
        for (int task = __builtin_amdgcn_readfirstlane(F.vcu * NWAVES + F.wave); task < (T / 64) * 4; task += F.G * NWAVES) {
            const int tile = task >> 2, g = task & 3, t0 = tile * 64, s0 = t0 & (SEQ - 1); const bool first = s0 == 0;
            bf16x8 Af[2][4];
#pragma unroll
            for (int ddb = 0; ddb < 2; ++ddb)
#pragma unroll
                for (int s_ = 0; s_ < 4; ++s_) Af[ddb][s_] = *(const GAS bf16x8*)(PWT + (g * 64 + 32 * ddb + r) * 64 + 16 * s_ + 8 * hh);
            v4u un[10];
#pragma unroll
            for (int i = 0; i < 10; ++i) { const int row = 8 * i + (F.lane >> 3), cc = F.lane & 7; un[i] = (v4u){0u, 0u, 0u, 0u};
                if (!(first && row < 16)) un[i] = *(const GAS v4u*)(PU + (size_t)(t0 - 16 + row) * 256 + g * 64 + cc * 8); }
#pragma unroll
            for (int i = 0; i < 10; ++i) { const int row = 8 * i + (F.lane >> 3), cc = F.lane & 7; *(LAS v4u*)(Uw + row * PS_ + cc * 8) = un[i]; }
            LDS_WAIT(); __builtin_amdgcn_wave_barrier(); asm volatile("" ::: "memory");
            float uu[79];
#pragma unroll
            for (int i = 0; i < 79; ++i) uu[i] = bf2f(Uw[(1 + i) * PS_ + c]);
            LDS_WAIT(); __builtin_amdgcn_wave_barrier(); asm volatile("" ::: "memory");
#define POOL_WIN(WIN) do { float sum = 0.f; _Pragma("unroll") for (int j = 1; j < WIN; ++j) sum += uu[15 - j]; \
                _Pragma("unroll") for (int k = 0; k < 64; ++k) { const float u = uu[15 + k]; sum += u; const int cnt = (s0 + k + 1 < WIN) ? s0 + k + 1 : WIN; \
                    Uw[k * PS_ + c] = (bf16)f2bf(sum * __builtin_amdgcn_rcpf((float)cnt) - u); sum -= uu[15 + k - WIN + 1]; } } while (0)
            if (g == 0) POOL_WIN(2); else if (g == 1) POOL_WIN(4); else if (g == 2) POOL_WIN(8); else POOL_WIN(16);
#undef POOL_WIN
            LDS_WAIT(); __builtin_amdgcn_wave_barrier(); asm volatile("" ::: "memory");
#pragma unroll
            for (int tb = 0; tb < 2; ++tb) {
                f32x16 acc[2] = {{}, {}};
#pragma unroll
                for (int s_ = 0; s_ < 4; ++s_) { const bf16x8 B = *(const LAS bf16x8*)(Uw + (32 * tb + r) * PS_ + 16 * s_ + 8 * hh);
#pragma unroll
                    for (int ddb = 0; ddb < 2; ++ddb) acc[ddb] = __builtin_amdgcn_mfma_f32_32x32x16_bf16(Af[ddb][s_], B, acc[ddb], 0, 0, 0); }
                bf16* orow = MIX + (size_t)(t0 + 32 * tb + r) * DM + 768 + g * 64 + 4 * hh;
#pragma unroll
                for (int ddb = 0; ddb < 2; ++ddb)
#pragma unroll
                    for (int q = 0; q < 4; ++q) *(GAS u64*)(orow + 32 * ddb + 8 * q) = (u64)pk2(acc[ddb][4 * q], acc[ddb][4 * q + 1]) | ((u64)pk2(acc[ddb][4 * q + 2], acc[ddb][4 * q + 3]) << 32);
            }
            LDS_WAIT(); __builtin_amdgcn_wave_barrier(); asm volatile("" ::: "memory");
        }
    }
}

__device__ __forceinline__ float sum16_dpp(float x) {
    x += __int_as_float(__builtin_amdgcn_update_dpp(0, __float_as_int(x), 0xB1, 0xf, 0xf, true));
    x += __int_as_float(__builtin_amdgcn_update_dpp(0, __float_as_int(x), 0x4E, 0xf, 0xf, true));
    x += __int_as_float(__builtin_amdgcn_update_dpp(0, __float_as_int(x), 0x141, 0xf, 0xf, true));
    x += __int_as_float(__builtin_amdgcn_update_dpp(0, __float_as_int(x), 0x140, 0xf, 0xf, true));
    return x;
}
__device__ __forceinline__ unsigned long long ld_sc1_u64(const void* p) { return __hip_atomic_load((const gu64*)p, RLX_AGENT); }
__device__ __forceinline__ void p2b_attention(Frame& F, unsigned char* ws, const float* relb, const float* lv, const float* subg, int l, char* ldsg) {
    LAS float* rt = (LAS float*)(F.lds + ATT_RT_OFF); LAS float* lamp = (LAS float*)(F.lds + ATT_LAM_OFF);
    for (int e = F.tid; e < 4 * 640; e += NWAVES * 64) { const int h = e / 640, j = e % 640, dist = 383 - j;
        float v = 0.f; if (dist < 0) v = -INFINITY; else if (dist < 128) v = (relb[t5_bucket(dist) * 4 + h] - relb[31 * 4 + h]) * LOG2E;
        rt[e] = v; }
    if (F.tid == 0) { float li; const float lam = lam_of(lv, l, li); lamp[0] = lam; lamp[1] = 1.f - li; }
    __syncthreads();
    const float lam = lamp[0], osc = lamp[1];
    const attn_body::bf16* Q = (const attn_body::bf16*)(ws + WS_Q); const attn_body::bf16* K = (const attn_body::bf16*)(ws + WS_K);
    const attn_body::bf16* V = (const attn_body::bf16*)(ws + WS_V); attn_body::bf16* OS = (attn_body::bf16*)(ws + WS_OSCR);
    const bf16* OSr = (const bf16*)(ws + WS_OSCR); bf16* MIX = (bf16*)(ws + WS_MIX);
    for (int pr = F.vcu; pr < 256; pr += F.G) {
        const int bh = pr >> 2, s = pr & 3, b = bh >> 2, h = bh & 3;
        for (int half = 0; half < 2; ++half) {
            const int qb = half ? 7 - s : s;
#if ATT_V2 == 3
            for (int m = 0; m < 2; ++m) attn_body::attn_unit3<0>(b, qb, Q + (h * 2 + m) * 64, K + (h * 2 + m) * 64, V + h * 128, OS + h * 256 + m * 128, ldsg, rt + h * 640);
#elif ATT_V2
            attn_body::attn_unit2<0>(b, qb, Q + (h * 2 + 0) * 64, K + (h * 2 + 0) * 64, V + h * 128, OS + h * 256, ldsg, rt + h * 640);
            attn_body::attn_unit2<1>(b, qb, Q + (h * 2 + 1) * 64, K + (h * 2 + 1) * 64, V + h * 128, OS + h * 256 + 128, ldsg, rt + h * 640, OS + h * 256, (attn_body::bf16*)MIX + h * 128, lam, osc, subg);
#else
            for (int sub = 0; sub < 4; ++sub) { const int m = sub >> 1, vh = sub & 1;
                attn_body::attn_unit<8>(b, qb, Q + (h * 2 + m) * 64, K + (h * 2 + m) * 64, V + h * 128 + vh * 64, OS + h * 256 + m * 128 + vh * 64, ldsg, rt + h * 640); }
#endif
#if ATT_V2 != 1
            VM_WAIT(); __syncthreads();
            const size_t row0 = (size_t)b * SEQ + qb * 256 + F.wave * 32;
            { const int c8 = (F.lane & 15) * 8; unsigned long long ld[8][4];
#pragma unroll
              for (int it = 0; it < 8; ++it) { const bf16* p0 = OSr + (row0 + it * 4 + (F.lane >> 4)) * 1024 + h * 256 + c8;
                  ld[it][0] = ld_sc1_u64(p0); ld[it][1] = ld_sc1_u64(p0 + 4); ld[it][2] = ld_sc1_u64(p0 + 128); ld[it][3] = ld_sc1_u64(p0 + 132); }
              const f32x4 g0 = *(const f32x4*)(subg + c8), g1 = *(const f32x4*)(subg + c8 + 4);
#pragma unroll
              for (int it = 0; it < 8; ++it) {
                const size_t row = row0 + it * 4 + (F.lane >> 4);
                const unsigned long long a0 = ld[it][0], a1 = ld[it][1], b0 = ld[it][2], b1 = ld[it][3];
                float d[8]; float ss = 0.f;
#pragma unroll
                for (int i = 0; i < 4; ++i) { d[i] = bf2f((bf16)(a0 >> (16 * i))) - lam * bf2f((bf16)(b0 >> (16 * i))); d[4 + i] = bf2f((bf16)(a1 >> (16 * i))) - lam * bf2f((bf16)(b1 >> (16 * i))); }
#pragma unroll
                for (int i = 0; i < 8; ++i) ss += d[i] * d[i];
                ss = sum16_dpp(ss);
                const float rn = osc * __builtin_amdgcn_rsqf(ss * (1.f / 128.f) + EPS);
                v4u o; o.x = pk2(d[0] * rn * g0[0], d[1] * rn * g0[1]); o.y = pk2(d[2] * rn * g0[2], d[3] * rn * g0[3]); o.z = pk2(d[4] * rn * g1[0], d[5] * rn * g1[1]); o.w = pk2(d[6] * rn * g1[2], d[7] * rn * g1[3]);
                *(GAS v4u*)(MIX + row * DM + h * 128 + c8) = o;
              } }
#endif
        }
    }
}
__device__ __forceinline__ void gla_recurrent(unsigned char* ws, const float* gng, int bh, int lane) {
    const int b = bh >> 2, h = bh & 3;
    const bf16* __restrict__ GQK = (const bf16*)(ws + WS_GQK); const bf16* __restrict__ GV = (const bf16*)(ws + WS_GV); const bf16* __restrict__ GR = (const bf16*)(ws + WS_GR);
    const float* __restrict__ AG = (const float*)(ws + WS_AG); bf16* __restrict__ MIX = (bf16*)(ws + WS_MIX);
    const float ng = gng[lane];
    float st[32];
#pragma unroll
    for (int d = 0; d < 32; ++d) st[d] = 0.f;
    const float scale = 0.17677669529663687f;
    for (int t = 0; t < SEQ; ++t) {
        const size_t row = (size_t)b * SEQ + t;
        const float v = bf2f(GV[row * 256 + h * 64 + lane]);
        const bf16* qp = GQK + row * 256 + h * 32; const bf16* kp = qp + 128; const float* ap = AG + row * 128 + h * 32;
        float o = 0.f;
#pragma unroll
        for (int d = 0; d < 32; ++d) { st[d] = fmaf(ap[d], st[d], bf2f(kp[d]) * v); o = fmaf(bf2f(qp[d]), st[d], o); }
        o *= scale;
        const float r = 1.0f / sqrtf(wave_sum(o * o) * (1.f / 64.f) + EPS);
        const float gr = bf2f(GR[row * 256 + h * 64 + lane]);
        MIX[row * DM + 512 + h * 64 + lane] = (bf16)f2bf(o * r * ng * (gr / (1.f + expf(-gr))));
    }
}

constexpr int NPH = 1 + 6 * DEPTH;
constexpr int FLAG_SKIP_ATTN = 1;
__global__ void __launch_bounds__(NWAVES * 64, 2) mk_fwd(Args args) {
    extern __shared__ __attribute__((aligned(16))) unsigned char lds[];
    Frame F;
#define PHASE_BEGIN() int tid_ = threadIdx.x; asm volatile("" : "+v"(tid_)); F.tid = tid_; F.lane = tid_ & 63; F.wave = __builtin_amdgcn_readfirstlane(tid_ >> 6); \
    unsigned long long z_ = 0; asm volatile("" : "+s"(z_)); unsigned char* ws = args.ws + z_
    F.lds = (LAS unsigned char*)lds;
    F.MISC = (volatile LAS unsigned*)(F.lds + MISC_OFF);
    F.G = gridDim.x; { const int bx = blockIdx.x; F.vcu = (F.G % 8 == 0) ? (bx % 8) * (F.G / 8) + bx / 8 : bx; }
    F.ctl = (gu32*)(args.ws + WS_CTL);
    for (int u = threadIdx.x; u < (LDS_BYTES - LDSCTL_OFF) / 4; u += NWAVES * 64) ((LAS unsigned*)(F.lds + LDSCTL_OFF))[u] = 0u;
    __syncthreads();
    const int lo = args.ph_lo, hi = args.ph_hi;
    XcdBarrier bar; bar.bar = (unsigned*)(F.ctl + CW_BAR) + args.bar_region * XCD_BAR_WORDS; bar.x = 0; bar.st = nullptr;
    if (hi - lo > 1) bar = xcd_barrier_post((unsigned*)(F.ctl + CW_BAR) + args.bar_region * XCD_BAR_WORDS, F.MISC + 8);
#define IN(k) (lo <= (k) && (k) < hi)
#define SEAM(k) do { if (IN(k) && IN((k) + 1)) xcd_barrier(bar); } while (0)
#ifndef NO_P0
    if (IN(0)) { PHASE_BEGIN(); (void)ws; p0_prologue(F, args); SEAM(0);
        if (PROBE_FLAGS & 8) { for (int rep = 0; rep < 8; ++rep) SEAM(0); } }
#endif
    for (int l = 0; l < DEPTH; ++l) {
        const int pb = 1 + 6 * l;
#ifndef NO_G1
        if (IN(pb + 0)) {
            PHASE_BEGIN(); bf16* wl = (bf16*)(ws + WS_W + (size_t)l * W_LAYER);
            pg8::Gemm g{(const bf16*)(ws + WS_HB), wl + WO_W1 / 2, T, N1P, DM}; pg8::StaticOrder S; S.init(T, N1P, F.G, (int)blockIdx.x, WGM_G1);
            pg8::EpiProj E{(LAS float*)(F.lds + RST_OFF), (const float*)(ws + WS_RSA), (bf16*)(ws + WS_Q), (bf16*)(ws + WS_K), (bf16*)(ws + WS_V), (bf16*)(ws + WS_GQK), (bf16*)(ws + WS_GLR),
                           args.in[I_QG] + l * 64, args.in[I_KG] + l * 64, attn_body::C2};
            pg8::gemm_phase<pg8::EpiProj, pg8::StaticOrder, true, true>(F.lds + RING_OFF, g, S, E);
            {
                const int nfull = ((T / 256) * (N1P / 256)) % F.G, bx = (int)blockIdx.x; constexpr int IL = P0_ITEMS / DEPTH;
                const int it0 = l * IL + P0_I1, it1 = (l + 1 < DEPTH) ? (l + 1) * IL + P0_I1 : DEPTH * IL;
                if (bx >= nfull) p0_weight_items(F, args, it0, it1, (bx - nfull) * NWAVES + F.wave, (F.G - nfull) * NWAVES);
            }
            SEAM(pb + 0);
        }
#endif
#ifndef NO_P2A
        if (IN(pb + 1)) { PHASE_BEGIN(); p2a_decay_pool(F, ws, args.in[I_GGW] + l * 16 * 128, args.in[I_GGB] + l * 128, l); SEAM(pb + 1); }
#endif
        if (IN(pb + 2)) {
            PHASE_BEGIN();
#ifndef NO_GLA
#if GLA_RECURRENT
            if (F.wave == 0 && F.vcu < NB * 4) gla_recurrent(ws, args.in[I_GNG] + l * 64, F.vcu, F.lane);
#else
            for (int rep = 0; rep < ((PROBE_FLAGS & 2) ? 2 : 1); ++rep)
            for (int cg = F.vcu; cg < NB * 4 * 4; cg += F.G) {
                LAS u64* snapall = (LAS u64*)(F.lds + RING_OFF + GLA_SNAP_OFF);
                gla_state_scan(ws, cg * 8, F.wave, F.lane, snapall);
                LDS_WAIT(); __syncthreads();
                gla_chunk_C(ws, args.in[I_GNG] + l * 64, cg * 8 + F.wave, F.lane, F.lds + RING_OFF + F.wave * GLA_SCR, snapall + F.wave * 512);
                __syncthreads();
            }
#endif
#endif
#ifndef NO_ATT
            if (!(args.flags & FLAG_SKIP_ATTN)) for (int rep = 0; rep < ((PROBE_FLAGS & 4) ? 2 : 1); ++rep) p2b_attention(F, ws, args.in[I_RELB], args.in[I_LV] + l * 256, args.in[I_SUBG] + l * 128, l, (char*)lds + RING_OFF);
#endif
            SEAM(pb + 2);
        }
#ifndef NO_G2
        if (IN(pb + 3)) {
            PHASE_BEGIN(); bf16* wl = (bf16*)(ws + WS_W + (size_t)l * W_LAYER);
            pg8::Gemm g{(const bf16*)(ws + WS_MIX), wl + WO_WO / 2, T, DM, DM}; pg8::StaticOrder S; S.init(T, DM, F.G, (int)blockIdx.x, WGM_G2);
            pg8::EpiRes<false> E{args.out, (bf16*)(ws + WS_HB), (float*)(ws + WS_RSF)};
            pg8::gemm_phase<pg8::EpiRes<false>, pg8::StaticOrder, true, true>(F.lds + RING_OFF, g, S, E);
            SEAM(pb + 3);
        }
#endif
#ifndef NO_G3
        if (IN(pb + 4)) {
            PHASE_BEGIN(); bf16* wl = (bf16*)(ws + WS_W + (size_t)l * W_LAYER);
            pg8::Gemm g{(const bf16*)(ws + WS_HB), wl + WO_WGU / 2, T, NGU, DM}; pg8::StaticOrder S; S.init(T, NGU, F.G, (int)blockIdx.x, WGM_G3);
            pg8::EpiGU E{(LAS float*)(F.lds + RST_OFF), (const float*)(ws + WS_RSF), (bf16*)(ws + WS_FF)};
            pg8::gemm_phase<pg8::EpiGU, pg8::StaticOrder, true, true>(F.lds + RING_OFF, g, S, E);
            SEAM(pb + 4);
        }
#endif
#ifndef NO_G4
        if (IN(pb + 5)) {
            PHASE_BEGIN(); bf16* wl = (bf16*)(ws + WS_W + (size_t)l * W_LAYER);
            pg8::Gemm g{(const bf16*)(ws + WS_FF), wl + WO_WD / 2, T, DM, FFN}; pg8::StaticOrder S; S.init(T, DM, F.G, (int)blockIdx.x, WGM_G4);
            if (l == DEPTH - 1) { pg8::EpiRes<true> E{args.out, (bf16*)(ws + WS_HB), (float*)(ws + WS_RSA)};
                pg8::gemm_phase<pg8::EpiRes<true>, pg8::StaticOrder, true, true>(F.lds + RING_OFF, g, S, E); }
            else { pg8::EpiRes<false> E{args.out, (bf16*)(ws + WS_HB), (float*)(ws + WS_RSA)};
                pg8::gemm_phase<pg8::EpiRes<false>, pg8::StaticOrder, true, true>(F.lds + RING_OFF, g, S, E); }
            SEAM(pb + 5);
        }
#endif
    }
#undef IN
#undef SEAM
#undef PHASE_BEGIN
}

#ifndef PROBE_DUP
#define PROBE_DUP (-1)
#endif
#ifndef MK_FAST
#define MK_FAST 0x1fff
#endif
#if MK_FAST != 0x1fff
namespace sk {
__device__ __forceinline__ float wsum(float v) {
#pragma unroll
    for (int o = 1; o < 64; o <<= 1) v += __shfl_xor(v, o);
    return v;
}
__device__ __forceinline__ float wmax(float v) {
#pragma unroll
    for (int o = 1; o < 64; o <<= 1) v = fmaxf(v, __shfl_xor(v, o));
    return v;
}
__device__ __forceinline__ float dot_bf16(const bf16* a, const bf16* b, int K) {
    float s = 0.f;
    for (int k = 0; k < K; k += 8) { const v4u x = *(const v4u*)(a + k), y = *(const v4u*)(b + k);
        const unsigned xs[4] = {x.x, x.y, x.z, x.w}, ys[4] = {y.x, y.y, y.z, y.w};
#pragma unroll
        for (int i = 0; i < 4; ++i) { s = fmaf(__builtin_bit_cast(float, xs[i] << 16), __builtin_bit_cast(float, ys[i] << 16), s);
            s = fmaf(__builtin_bit_cast(float, xs[i] & 0xffff0000u), __builtin_bit_cast(float, ys[i] & 0xffff0000u), s); } }
    return s;
}
__device__ __forceinline__ float rs_of(const float* rowsq, int row) { float s = 0.f; for (int i = 0; i < 16; ++i) s += rowsq[(size_t)row * 16 + i]; return 1.0f / sqrtf(s * (1.f / 1024.f) + EPS); }
__global__ void __launch_bounds__(256) p0_weights(Args a) {
    const size_t per_layer = (size_t)(N1P + DM + NGU) * DM + (size_t)DM * FFN;
    for (size_t idx = (size_t)blockIdx.x * 256 + threadIdx.x; idx < DEPTH * per_layer; idx += (size_t)gridDim.x * 256) {
        const int l = (int)(idx / per_layer); size_t r = idx % per_layer;
        bf16* wl = (bf16*)(a.ws + WS_W + (size_t)l * W_LAYER);
        if (r < (size_t)N1P * DM) { const int p = (int)(r / DM), k = (int)(r % DM); const int c = w1_src_col(p);
            const float v = c < 0 ? 0.f : a.in[I_WIN][(size_t)l * DM * NIN + (size_t)k * NIN + c] * a.in[I_ATTN_G][l * DM + k];
            wl[WO_W1 / 2 + r] = (bf16)f2bf(v); continue; }
        r -= (size_t)N1P * DM;
        if (r < (size_t)DM * DM) { const int n = (int)(r / DM), k = (int)(r % DM); wl[WO_WO / 2 + r] = (bf16)f2bf(a.in[I_WOUT][(size_t)l * DM * DM + (size_t)k * DM + n]); continue; }
        r -= (size_t)DM * DM;
        if (r < (size_t)NGU * DM) { const int p = (int)(r / DM), k = (int)(r % DM), pn = p >> 8, bj = (p >> 7) & 1, jj = p & 127;
            const float v = (bj ? a.in[I_WU] : a.in[I_WG])[(size_t)l * DM * FFN + (size_t)k * FFN + 128 * pn + jj] * a.in[I_FFN_G][l * DM + k];
            wl[WO_WGU / 2 + r] = (bf16)f2bf(v); continue; }
        r -= (size_t)NGU * DM;
        { const int n = (int)(r / FFN), k = (int)(r % FFN); wl[WO_WD / 2 + r] = (bf16)f2bf(a.in[I_WD][(size_t)l * FFN * DM + (size_t)k * DM + n]); }
    }
}
__global__ void __launch_bounds__(256) p0_rows(Args a) {
    const int row = blockIdx.x * 4 + (threadIdx.x >> 6), lane = threadIdx.x & 63;
    bf16* HB = (bf16*)(a.ws + WS_HB); float* RSA = (float*)(a.ws + WS_RSA);
    float s = 0.f;
    for (int c = lane; c < DM; c += 64) { const float v = a.in[I_X][(size_t)row * DM + c]; s += v * v; HB[(size_t)row * DM + c] = (bf16)f2bf(v); }
    s = wsum(s);
    if (lane < 16) RSA[(size_t)row * 16 + lane] = lane == 0 ? s : 0.f;
}
__global__ void __launch_bounds__(256) gemm1(Args a, int l) {
    const int gwv = blockIdx.x * 4 + (threadIdx.x >> 6), lane = threadIdx.x & 63;
    const int row = gwv / 41, grp = gwv % 41;
    const bf16* HB = (const bf16*)(a.ws + WS_HB); const bf16* W1 = (const bf16*)(a.ws + WS_W + (size_t)l * W_LAYER + WO_W1);
    int p;
    if (grp < 40) { const int L = grp * 64 + lane; p = 256 * (L >> 8) + 128 * ((L >> 5) & 1) + 32 * ((L >> 6) & 3) + (L & 31); } else p = 2560 + (lane & 15);
    const float val = dot_bf16(HB + (size_t)row * DM, W1 + (size_t)p * DM, DM) * rs_of((const float*)(a.ws + WS_RSA), row);
    if (grp < 16) { const float rn = 1.0f / sqrtf(wsum(val * val) * (1.f / 64.f) + EPS);
        if (grp < 8) ((bf16*)(a.ws + WS_Q))[(size_t)row * 512 + grp * 64 + lane] = (bf16)f2bf(val * rn * a.in[I_QG][l * 64 + lane] * attn_body::C2);
        else ((bf16*)(a.ws + WS_K))[(size_t)row * 512 + (grp - 8) * 64 + lane] = (bf16)f2bf(val * rn * a.in[I_KG][l * 64 + lane]); }
    else if (grp < 24) ((bf16*)(a.ws + WS_V))[(size_t)row * 512 + (grp - 16) * 64 + lane] = (bf16)f2bf(val);
    else if (grp < 28) ((bf16*)(a.ws + WS_GQK))[(size_t)row * 256 + (grp - 24) * 64 + lane] = (bf16)f2bf(val);
    else if (grp < 32) ((bf16*)(a.ws + WS_GV))[(size_t)row * 256 + (grp - 28) * 64 + lane] = (bf16)f2bf(val);
    else if (grp < 36) ((bf16*)(a.ws + WS_GR))[(size_t)row * 256 + (grp - 32) * 64 + lane] = (bf16)f2bf(val);
    else if (grp < 40) ((bf16*)(a.ws + WS_PU))[(size_t)row * 256 + (grp - 36) * 64 + lane] = (bf16)f2bf(val);
    else if (grp == 40 && lane < 16) ((bf16*)(a.ws + WS_GLR))[(size_t)row * 16 + lane] = (bf16)f2bf(val);
}
__global__ void __launch_bounds__(256) gemm_res(Args a, const bf16* A, const bf16* Bt, int K, float* rowsq_out, int final_) {
    const int gwv = blockIdx.x * 4 + (threadIdx.x >> 6), lane = threadIdx.x & 63;
    const int row = gwv >> 4, ch = gwv & 15, c = ch * 64 + lane;
    bf16* HB = (bf16*)(a.ws + WS_HB);
    const float h = bf2f(HB[(size_t)row * DM + c]) + dot_bf16(A + (size_t)row * K, Bt + (size_t)c * K, K);
    if (final_) { a.out[(size_t)row * DM + c] = h; return; }
    HB[(size_t)row * DM + c] = (bf16)f2bf(h);
    const float ss = wsum(h * h);
    if (lane == 0) rowsq_out[(size_t)row * 16 + ch] = ss;
}
__global__ void __launch_bounds__(256) gemm3(Args a, int l) {
    const int gwv = blockIdx.x * 4 + (threadIdx.x >> 6), lane = threadIdx.x & 63;
    const int row = gwv / 44, c = (gwv % 44) * 64 + lane, pn = c >> 7, jj = c & 127;
    const bf16* HB = (const bf16*)(a.ws + WS_HB); const bf16* W = (const bf16*)(a.ws + WS_W + (size_t)l * W_LAYER + WO_WGU);
    const float r = rs_of((const float*)(a.ws + WS_RSF), row);
    const float g = dot_bf16(HB + (size_t)row * DM, W + (size_t)(256 * pn + jj) * DM, DM) * r, u = dot_bf16(HB + (size_t)row * DM, W + (size_t)(256 * pn + 128 + jj) * DM, DM) * r;
    ((bf16*)(a.ws + WS_FF))[(size_t)row * FFN + c] = (bf16)f2bf(g / (1.f + expf(-g)) * u);
}
__global__ void __launch_bounds__(128) attn(Args a, int l) {
    __shared__ float sc[2][2][SEQ];
    __shared__ float biasd[SEQ];
    const int wv = threadIdx.x >> 6, lane = threadIdx.x & 63;
    const int h = blockIdx.y, b = blockIdx.z, q = blockIdx.x * 2 + wv;
    for (int d = threadIdx.x; d < SEQ; d += 128) biasd[d] = a.in[I_RELB][t5_bucket(d) * 4 + h] * LOG2E;
    __syncthreads();
    float lam_init; const float lam = lam_of(a.in[I_LV] + l * 256, l, lam_init);
    const bf16* Q = (const bf16*)(a.ws + WS_Q); const bf16* K = (const bf16*)(a.ws + WS_K); const bf16* V = (const bf16*)(a.ws + WS_V);
    float lsum[2];
    for (int m = 0; m < 2; ++m) {
        const bf16* qp = Q + (size_t)(b * SEQ + q) * 512 + (h * 2 + m) * 64;
        float mx = -1e30f;
        for (int k = lane; k <= q; k += 64) {
            const float s = dot_bf16(qp, K + (size_t)(b * SEQ + k) * 512 + (h * 2 + m) * 64, 64) + biasd[q - k];
            sc[wv][m][k] = s; mx = fmaxf(mx, s);
        }
        mx = wmax(mx);
        float sum = 0.f;
        for (int k = lane; k <= q; k += 64) { const float p = exp2f(sc[wv][m][k] - mx); sc[wv][m][k] = p; sum += p; }
        lsum[m] = wsum(sum);
    }
    const float i0 = 1.f / lsum[0], i1 = lam / lsum[1];
    for (int k = lane; k <= q; k += 64) sc[wv][0][k] = sc[wv][0][k] * i0 - sc[wv][1][k] * i1;
    __builtin_amdgcn_s_waitcnt(0);
    __builtin_amdgcn_wave_barrier();
    float o0 = 0.f, o1 = 0.f;
    const bf16* vp = V + (size_t)(b * SEQ) * 512 + h * 128 + lane;
    for (int k = 0; k <= q; ++k) { const float w = sc[wv][0][k]; o0 = fmaf(w, bf2f(vp[(size_t)k * 512]), o0); o1 = fmaf(w, bf2f(vp[(size_t)k * 512 + 64]), o1); }
    const float r = 1.0f / sqrtf(wsum(o0 * o0 + o1 * o1) * (1.f / 128.f) + EPS) * (1.f - lam_init);
    bf16* mp = (bf16*)(a.ws + WS_MIX) + (size_t)(b * SEQ + q) * DM + h * 128 + lane;
    mp[0] = (bf16)f2bf(o0 * r * a.in[I_SUBG][l * 128 + lane]); mp[64] = (bf16)f2bf(o1 * r * a.in[I_SUBG][l * 128 + lane + 64]);
}
}
#endif

extern "C" void kernel_launch(void* const* d_in, const int* in_sizes, int n_in, void* d_out, int out_size, void* d_ws, size_t ws_size, hipStream_t stream) {
    static int grid = 0;
    if (grid == 0) {
        if (n_in != 18 || in_sizes[0] != T * DM || out_size != T * DM || ws_size < WS_END) { fprintf(stderr, "kernel_launch: unexpected shapes / workspace (n_in %d, ws %zu)\n", n_in, ws_size); grid = -1; return; }
        int dev = 0, cus = 0, per_cu = 0;
        if (hipGetDevice(&dev) != hipSuccess || hipDeviceGetAttribute(&cus, hipDeviceAttributeMultiprocessorCount, dev) != hipSuccess) { grid = -1; return; }
        if (hipFuncSetAttribute((const void*)mk_fwd, hipFuncAttributeMaxDynamicSharedMemorySize, LDS_BYTES) != hipSuccess) { fprintf(stderr, "kernel_launch: hipFuncSetAttribute failed\n"); grid = -1; return; }
        if (hipOccupancyMaxActiveBlocksPerMultiprocessor(&per_cu, (const void*)mk_fwd, NWAVES * 64, LDS_BYTES) != hipSuccess || per_cu < 1) { fprintf(stderr, "kernel_launch: occupancy query says %d blocks per CU\n", per_cu); (void)hipGetLastError(); per_cu = 1; }
        grid = cus;
    }
    if (grid < 0) return;
    (void)hipMemsetAsync((char*)d_ws + WS_CTL, 0, CTL_ZERO_BYTES, stream);
    Args a{};
    for (int i = 0; i < 18; ++i) a.in[i] = (const float*)d_in[i];
    a.out = (float*)d_out; a.ws = (unsigned char*)d_ws;
#if MK_FAST == 0x1fff
    a.ph_lo = 0; a.ph_hi = NPH; a.flags = 0;
    void* kargs[] = {&a};
#if PROBE_DUP >= 0
    a.ph_hi = PROBE_DUP + 1; (void)hipLaunchCooperativeKernel((const void*)mk_fwd, dim3(grid), dim3(NWAVES * 64), kargs, LDS_BYTES, stream);
    a.ph_lo = PROBE_DUP; a.ph_hi = NPH; a.bar_region = 1;
#endif
    hipError_t e = hipLaunchCooperativeKernel((const void*)mk_fwd, dim3(grid), dim3(NWAVES * 64), kargs, LDS_BYTES, stream);
    if (e != hipSuccess) fprintf(stderr, "kernel_launch: cooperative launch failed: %s (grid %d)\n", hipGetErrorString(e), grid);
#else
    auto run_fast = [&](int p, int flags) { Args b = a; b.ph_lo = p; b.ph_hi = p + 1; b.flags = flags; hipLaunchKernelGGL(mk_fwd, dim3(grid), dim3(NWAVES * 64), LDS_BYTES, stream, b); };
    const unsigned fast = MK_FAST;
    unsigned char* ws = (unsigned char*)d_ws;
    if (fast & 1u) run_fast(0, 0); else { sk::p0_weights<<<4096, 256, 0, stream>>>(a); sk::p0_rows<<<T / 4, 256, 0, stream>>>(a); }
    for (int l = 0; l < DEPTH; ++l) {
        const int pb = 1 + 6 * l;
        const bf16* wl = (const bf16*)(ws + WS_W + (size_t)l * W_LAYER);
        if (fast & (1u << (pb + 0))) run_fast(pb + 0, 0); else { sk::p0_weights<<<4096, 256, 0, stream>>>(a);
            sk::gemm1<<<T * 41 / 4, 256, 0, stream>>>(a, l); }
        run_fast(pb + 1, 0);
        if (fast & (1u << (pb + 2))) run_fast(pb + 2, 0); else { sk::attn<<<dim3(SEQ / 2, 4, NB), 128, 0, stream>>>(a, l); run_fast(pb + 2, FLAG_SKIP_ATTN); }
        if (fast & (1u << (pb + 3))) run_fast(pb + 3, 0); else sk::gemm_res<<<T * 16 / 4, 256, 0, stream>>>(a, (const bf16*)(ws + WS_MIX), wl + WO_WO / 2, DM, (float*)(ws + WS_RSF), 0);
        if (fast & (1u << (pb + 4))) run_fast(pb + 4, 0); else sk::gemm3<<<T * 44 / 4, 256, 0, stream>>>(a, l);
        if (fast & (1u << (pb + 5))) run_fast(pb + 5, 0); else sk::gemm_res<<<T * 16 / 4, 256, 0, stream>>>(a, (const bf16*)(ws + WS_FF), wl + WO_WD / 2, FFN, (float*)(ws + WS_RSA), l == DEPTH - 1);
    }
#endif
}
```
